# Optimizing an MI355X kernel written in HIP

```python
import math
import jax
import jax.numpy as jnp
from jax import lax
import numpy as np

D_MODEL = 1024
BATCH = 2
SEQ = 8192
DEPTH = 4

D_MIX = D_MODEL
D_CONV = D_MIX // 2
CONV_GROUPS = 8
D_GLA = D_MIX - D_CONV
GLA_HEADS = 4
HEAD_V = D_GLA // GLA_HEADS
HEAD_K = HEAD_V // 2
D_GLA_K = GLA_HEADS * HEAD_K
GATE_RANK = 16
GATE_NORMALIZER = 16.0
CHUNK = 64
D_FF = 2816
CONV_WIDTH = 3
EPS = 1e-6
SPLIT_SIZES = (D_CONV, D_CONV, D_CONV,
               D_GLA_K, D_GLA_K, D_GLA, D_GLA,
               GATE_RANK, GATE_RANK)
D_IN = sum(SPLIT_SIZES)

kernel_name = "hybrid_shortconv_gla_convffn_encoder"


def rmsnorm(x, g):
    xf = x.astype(jnp.float32)
    y = xf * lax.rsqrt(jnp.mean(xf * xf, axis=-1, keepdims=True) + EPS)
    return (y * g.astype(jnp.float32)).astype(x.dtype)


def dwconv3(x, w):
    xp = jnp.pad(x, ((0, 0), (1, 1), (0, 0)))
    return w[0] * xp[:, :-2] + w[1] * xp[:, 1:-1] + w[2] * xp[:, 2:]


def split_cols(p):
    idx, acc = [], 0
    for s in SPLIT_SIZES[:-1]:
        acc += s
        idx.append(acc)
    return jnp.split(p, idx, axis=-1)


def gla_chunked(q, k, v, log_a):
    b_, h_, L, dk = q.shape
    dv = v.shape[-1]
    n = L // CHUNK
    q = q.reshape(b_, h_, n, CHUNK, dk)
    k = k.reshape(b_, h_, n, CHUNK, dk)
    v = v.reshape(b_, h_, n, CHUNK, dv)
    cum = jnp.cumsum(log_a.reshape(b_, h_, n, CHUNK, dk), axis=3)
    cum_last = cum[:, :, :, -1:, :]
    q_in = q * jnp.exp(cum)
    k_in = k * jnp.exp(-cum)
    k_out = k * jnp.exp(cum_last - cum)
    mask = jnp.tril(jnp.ones((CHUNK, CHUNK), dtype=bool))
    scores = jnp.einsum('bhnid,bhnjd->bhnij', q_in, k_in)
    scores = jnp.where(mask, scores, 0.0)
    o_intra = jnp.einsum('bhnij,bhnje->bhnie', scores, v)
    kv = jnp.einsum('bhnjd,bhnje->bhnde', k_out, v)
    decay = jnp.exp(cum_last[:, :, :, 0, :])

    def step(state, inp):
        d_n, kv_n = inp
        return d_n[..., None] * state + kv_n, state

    _, s_prev = lax.scan(step, jnp.zeros((b_, h_, dk, dv), jnp.float32),
                         (jnp.moveaxis(decay, 2, 0), jnp.moveaxis(kv, 2, 0)))
    s_prev = jnp.moveaxis(s_prev, 0, 2)
    o_inter = jnp.einsum('bhnid,bhnde->bhnie', q_in, s_prev)
    return (o_intra + o_inter).reshape(b_, h_, L, dv)


def to_heads(t, d_head):
    b_, L, _ = t.shape
    return t.reshape(b_, L, -1, d_head).transpose(0, 2, 1, 3)


def gate_log_decay(lr, w_up, bias):
    pre = (lr @ w_up + bias).astype(jnp.float32)
    return jax.nn.log_sigmoid(pre) / GATE_NORMALIZER


def mixer(h, w_in, conv_a, gate_up_fwd, gate_bias_fwd, gate_up_bwd, gate_bias_bwd,
          gla_head_norm, w_out):
    p = h @ w_in
    gb, gc, gv, q, k, v, go, lr_f, lr_b = split_cols(p)
    y_a = gb * dwconv3(gc * gv, conv_a)
    la_f = gate_log_decay(lr_f, gate_up_fwd, gate_bias_fwd)
    la_b = gate_log_decay(lr_b, gate_up_bwd, gate_bias_bwd)
    qh = to_heads(q, HEAD_K).astype(jnp.float32) * (HEAD_K ** -0.5)
    kh = to_heads(k, HEAD_K).astype(jnp.float32)
    vh = to_heads(v, HEAD_V).astype(jnp.float32)
    af = to_heads(la_f, HEAD_K)
    ab = to_heads(la_b, HEAD_K)
    flip = lambda t: jnp.flip(t, axis=2)
    o_f = gla_chunked(qh, kh, vh, af)
    o_b = flip(gla_chunked(flip(qh), flip(kh), flip(vh), flip(ab)))
    o = o_f + o_b
    o = o * lax.rsqrt(jnp.mean(o * o, axis=-1, keepdims=True) + EPS) * gla_head_norm.astype(jnp.float32)
    b_, _, L, _ = o.shape
    o = o.transpose(0, 2, 1, 3).reshape(b_, L, D_GLA).astype(h.dtype)
    y_b = jax.nn.silu(go) * o
    y = jnp.concatenate([y_a, y_b], axis=-1)
    return y @ w_out


def conv_mlp(h, w_up, conv_w, w_down):
    u = dwconv3(h @ w_up, conv_w)
    gate, val = jnp.split(u, 2, axis=-1)
    return (jax.nn.silu(gate) * val) @ w_down


def setup_inputs(seed: int = 0) -> dict:
    key = jax.random.key(seed)
    ks = jax.random.split(key, 20)
    f32 = jnp.float32
    nrm = lambda k, shape, scale: jax.random.normal(k, shape, f32) * scale
    gain = lambda k, shape: 1.0 + 0.05 * jax.random.normal(k, shape, f32)
    return {
        "x": jax.random.normal(ks[0], (BATCH, SEQ, D_MODEL), f32),
        "norm_mix_pre": gain(ks[1], (DEPTH, D_MODEL)),
        "norm_mix_post": gain(ks[2], (DEPTH, D_MODEL)),
        "norm_ffn_pre": gain(ks[3], (DEPTH, D_MODEL)),
        "norm_ffn_post": gain(ks[4], (DEPTH, D_MODEL)),
        "w_in": nrm(ks[5], (DEPTH, D_MODEL, D_IN), D_MODEL ** -0.5),
        "conv_a": nrm(ks[6], (DEPTH, CONV_WIDTH, D_CONV), CONV_WIDTH ** -0.5),
        "gate_up_fwd": nrm(ks[7], (DEPTH, GATE_RANK, D_GLA_K), GATE_RANK ** -0.5),
        "gate_bias_fwd": nrm(ks[8], (DEPTH, D_GLA_K), 0.1),
        "gate_up_bwd": nrm(ks[9], (DEPTH, GATE_RANK, D_GLA_K), GATE_RANK ** -0.5),
        "gate_bias_bwd": nrm(ks[10], (DEPTH, D_GLA_K), 0.1),
        "gla_head_norm": gain(ks[11], (DEPTH, HEAD_V)),
        "w_out": nrm(ks[12], (DEPTH, D_MIX, D_MODEL), D_MIX ** -0.5),
        "w_up": nrm(ks[13], (DEPTH, D_MODEL, 2 * D_FF), D_MODEL ** -0.5),
        "conv_ffn": nrm(ks[14], (DEPTH, CONV_WIDTH, 2 * D_FF), CONV_WIDTH ** -0.5),
        "w_down": nrm(ks[15], (DEPTH, D_FF, D_MODEL), D_FF ** -0.5),
    }


def reference(x, norm_mix_pre, norm_mix_post, norm_ffn_pre, norm_ffn_post, w_in, conv_a,
              gate_up_fwd, gate_bias_fwd, gate_up_bwd, gate_bias_bwd, gla_head_norm,
              w_out, w_up, conv_ffn, w_down):
    for l in range(DEPTH):
        h = rmsnorm(x, norm_mix_pre[l])
        y = mixer(h, w_in[l], conv_a[l], gate_up_fwd[l], gate_bias_fwd[l], gate_up_bwd[l],
                  gate_bias_bwd[l], gla_head_norm[l], w_out[l])
        x = x + rmsnorm(y, norm_mix_post[l])
        h = rmsnorm(x, norm_ffn_pre[l])
        y = conv_mlp(h, w_up[l], conv_ffn[l], w_down[l])
        x = x + rmsnorm(y, norm_ffn_post[l])
    return x
```

```cpp
#include <hip/hip_runtime.h>
#include <hip/hip_cooperative_groups.h>
#include <cstdio>
#include <cstdint>
namespace cg = cooperative_groups;
#define ONE_LAUNCH 1
namespace pg8 {
#define PG8_LAS __attribute__((address_space(3)))
typedef unsigned short bf16_t;
typedef short bf16x8 __attribute__((ext_vector_type(8)));
typedef float f32x4 __attribute__((ext_vector_type(4)));
typedef unsigned u32x4 __attribute__((ext_vector_type(4)));
constexpr int BM = 256, BK = 64, HALF = 128, HTB = HALF * BK * 2  , STAGE_BYTES = 8 * HTB, NXCD = 8, WGM = 8;

__host__ __device__ __forceinline__ int lds_byte(int r, int c) { const int st = (r >> 4) * 2 + (c >> 5), rr = r & 15, cc = c & 31, ob = rr * 64 + cc * 2; return st * 1024 + (ob ^ (((ob >> 9) & 1) << 5)); }
__host__ __device__ __forceinline__ void stage_rc(int b, int& R, int& C) { const int st = b / 1024, sb = b % 1024, swz = sb ^ (((sb >> 9) & 1) << 5); R = (st >> 1) * 16 + swz / 64; C = (st & 1) * 32 + (swz % 64) / 2; }
__host__ __device__ __forceinline__ int perm32(int rho) { const int n = rho >> 4, i = rho & 15; return 8 * (i >> 2) + 4 * n + (i & 3); }

struct Unit { int pm, pn; };
struct Gemm { const bf16_t* A; const bf16_t* Bt; int M, N, K; };

struct StaticOrder {
    int nM, nN, nwg, G, c;
    __host__ __device__ void init(int M, int N, int G_, int c_) { nM = M / BM; nN = N / BM; nwg = nM * nN; G = G_; c = c_; }
    __host__ __device__ bool next(int i, Unit& u) const {
        const long L = (long)i * G + c; if (L >= nwg) return false;
        int wgid = (int)L; { const int q = nwg / NXCD, r = nwg % NXCD, xcd = wgid % NXCD, off = wgid / NXCD; wgid = (xcd < r ? xcd * (q + 1) : r * (q + 1) + (xcd - r) * q) + off; }
        const int nig = WGM * nN, gid = wgid / nig, fm = gid * WGM, gsz = (nM - fm) < WGM ? (nM - fm) : WGM;
        u.pm = fm + ((wgid % nig) % gsz); u.pn = (wgid % nig) / gsz; return true;
    }
    __device__ __forceinline__ void a_ready(const Unit&) const {}
    __device__ __forceinline__ void done(const Unit&) const {}
};

__device__ __forceinline__ unsigned cvt_pk_bf16(float lo, float hi) { unsigned r; asm volatile("v_cvt_pk_bf16_f32 %0, %1, %2" : "=v"(r) : "v"(lo), "v"(hi)); return r; }
typedef unsigned u32x2e __attribute__((ext_vector_type(2)));
struct EpiBf16 {
    static constexpr bool PERM = true, AFTER_DRAIN = false;
    bf16_t* O; int ldc;
    __device__ __forceinline__ void operator()(const f32x4 (&acc)[2][2][4][2], const Unit& u, int wr, int wc, int fr, int fq) const {
        const int row0 = u.pm * BM + wr * 64 + fr; const int col0 = u.pn * BM + wc * 32 + 8 * fq;
#pragma unroll
        for (int ai = 0; ai < 2; ++ai)
#pragma unroll
            for (int m = 0; m < 4; ++m) { bf16_t* rowp = O + (size_t)(row0 + ai * HALF + m * 16) * ldc + col0;
#pragma unroll
                for (int bj = 0; bj < 2; ++bj) { const f32x4 v0 = acc[ai][bj][m][0], v1 = acc[ai][bj][m][1];
                    u32x4 w; w.x = cvt_pk_bf16(v0[0], v0[1]); w.y = cvt_pk_bf16(v0[2], v0[3]); w.z = cvt_pk_bf16(v1[0], v1[1]); w.w = cvt_pk_bf16(v1[2], v1[3]);
                    *(u32x4*)(rowp + bj * HALF) = w; } }
    }
};
struct EpiF32 {
    static constexpr bool PERM = false, AFTER_DRAIN = false;
    float* O; int ldc;
    __device__ __forceinline__ void operator()(const f32x4 (&acc)[2][2][4][2], const Unit& u, int wr, int wc, int fr, int fq) const {
        const int row0 = u.pm * BM + wr * 64 + fr; const int col0 = u.pn * BM + wc * 32 + 4 * fq;
#pragma unroll
        for (int ai = 0; ai < 2; ++ai)
#pragma unroll
            for (int m = 0; m < 4; ++m) { float* rowp = O + (size_t)(row0 + ai * HALF + m * 16) * ldc + col0;
#pragma unroll
                for (int bj = 0; bj < 2; ++bj)
#pragma unroll
                    for (int n = 0; n < 2; ++n) *(f32x4*)(rowp + bj * HALF + n * 16) = acc[ai][bj][m][n]; }
    }
};
template <class Epi, class Sched, bool ALIGN_EPI = false, bool SP2 = false>
__device__ __forceinline__ void gemm_phase(const int tid_in, PG8_LAS unsigned char* lds, const Gemm g, const Sched& S, const Epi& E) {
    const int tid = tid_in, wid = __builtin_amdgcn_readfirstlane(tid >> 6), lane = tid & 63, wr = wid >> 2, wc = wid & 3, fr = lane & 15, fq = lane >> 4;
    const int K = g.K, nt = K / BK;
    unsigned voffA[2], voffB[2];
#pragma unroll
    for (int i = 0; i < 2; ++i) { int R, C; stage_rc(tid * 16 + i * 8192, R, C); const int Rb = Epi::PERM ? ((R & ~31) + perm32(R & 31)) : R;
        voffA[i] = (unsigned)(R * K + C) * 2u; voffB[i] = (unsigned)(Rb * K + C) * 2u; }
    const size_t kstep = (size_t)(BK * 2);
    const size_t hstep = (size_t)HALF * K * 2;
    const size_t tstep = 2 * hstep;
    const unsigned ldsw = (unsigned)wid * 1024u;
    const int aoff = lds_byte(wr * 64 + fr, fq * 8), boff = lds_byte(wc * 32 + fr, fq * 8);
#define PG8_SA(b, h) (((b) * 2 + (h)) * HTB)
#define PG8_SB(b, h) ((4 + (b) * 2 + (h)) * HTB)
#define PG8_STAGE(bufoff, gbase, voff) do { _Pragma("unroll") for (int _i = 0; _i < 2; ++_i) \
        __builtin_amdgcn_global_load_lds((const unsigned*)((const char*)(gbase) + (voff)[_i]), (PG8_LAS unsigned*)(lds + (bufoff) + ldsw + _i * 8192), 16, 0, 0); } while (0)
#define PG8_LDA(dst, b, h) do { _Pragma("unroll") for (int m = 0; m < 4; ++m) _Pragma("unroll") for (int k = 0; k < 2; ++k) dst[m][k] = *(const PG8_LAS bf16x8*)(lds + PG8_SA(b, h) + aoff + m * 2048 + k * 1024); } while (0)
#define PG8_LDB(dst, b, h) do { _Pragma("unroll") for (int n = 0; n < 2; ++n) _Pragma("unroll") for (int k = 0; k < 2; ++k) dst[n][k] = *(const PG8_LAS bf16x8*)(lds + PG8_SB(b, h) + boff + n * 2048 + k * 1024); } while (0)
#define PG8_MMA(ai, bj, At, Bt) do { __builtin_amdgcn_s_setprio(1); _Pragma("unroll") for (int m = 0; m < 4; ++m) _Pragma("unroll") for (int n = 0; n < 2; ++n) _Pragma("unroll") for (int k = 0; k < 2; ++k) \
        acc[ai][bj][m][n] = __builtin_amdgcn_mfma_f32_16x16x32_bf16(Bt[n][k], At[m][k], acc[ai][bj][m][n], 0, 0, 0); __builtin_amdgcn_s_setprio(0); } while (0)
#define PG8_WAIT_V(n) asm volatile("s_waitcnt vmcnt(" #n ")" ::: "memory")
#define PG8_WAIT_L(n) asm volatile("s_waitcnt lgkmcnt(" #n ")" ::: "memory")
#define PG8_BAR __builtin_amdgcn_s_barrier()
#define PG8_SCHED __builtin_amdgcn_sched_barrier(0)
    Unit cur, nxt; int ui = 0;
    if (!S.next(0, cur)) return;
    f32x4 acc[2][2][4][2];
#pragma unroll
    for (int a = 0; a < 2; ++a)
#pragma unroll
        for (int b = 0; b < 2; ++b)
#pragma unroll
            for (int m = 0; m < 4; ++m)
#pragma unroll
                for (int n = 0; n < 2; ++n) acc[a][b][m][n] = (f32x4){0.f, 0.f, 0.f, 0.f};
    bf16x8 At[4][2], B0[2][2], B1[2][2];
    const char* cA = (const char*)g.A + (size_t)cur.pm * tstep; const char* cB = (const char*)g.Bt + (size_t)cur.pn * tstep;
    S.a_ready(cur);
    if constexpr (SP2) {
        PG8_STAGE(PG8_SB(0, 0), cB, voffB); PG8_STAGE(PG8_SB(0, 1), cB + hstep, voffB); PG8_STAGE(PG8_SA(0, 0), cA, voffA); PG8_STAGE(PG8_SA(0, 1), cA + hstep, voffA);
        if (wr == 1) PG8_BAR;
        PG8_WAIT_V(2); PG8_BAR;
        PG8_STAGE(PG8_SB(1, 0), cB + kstep, voffB); PG8_STAGE(PG8_SA(1, 0), cA + kstep, voffA); PG8_STAGE(PG8_SB(1, 1), cB + hstep + kstep, voffB);
        PG8_WAIT_V(6); PG8_BAR;
    } else {
        PG8_STAGE(PG8_SB(0, 0), cB, voffB); PG8_STAGE(PG8_SA(0, 0), cA, voffA); PG8_STAGE(PG8_SB(0, 1), cB + hstep, voffB); PG8_STAGE(PG8_SA(0, 1), cA + hstep, voffA);
        if (wr == 1) PG8_BAR;
        PG8_WAIT_V(4); PG8_BAR;
        PG8_STAGE(PG8_SB(1, 0), cB + kstep, voffB); PG8_STAGE(PG8_SA(1, 0), cA + kstep, voffA); PG8_STAGE(PG8_SB(1, 1), cB + hstep + kstep, voffB);
        PG8_WAIT_V(6); PG8_BAR;
    }
    for (;;) {
        const bool has_next = S.next(ui + 1, nxt);
        const char* nA = has_next ? (const char*)g.A + (size_t)nxt.pm * tstep : cA; const char* nB = has_next ? (const char*)g.Bt + (size_t)nxt.pn * tstep : cB;
        for (int t = 0; t < nt; t += 2) {
            const bool last = (t == nt - 2);
            const char* a1 = cA + (size_t)(t + 1) * kstep;
            const char* a2 = last ? nA : cA + (size_t)(t + 2) * kstep; const char* b2 = last ? nB : cB + (size_t)(t + 2) * kstep;
            const char* a3 = a2 + kstep; const char* b3 = b2 + kstep;
            if (last && has_next) S.a_ready(nxt);
            if constexpr (SP2) {
            PG8_LDB(B0, 0, 0); PG8_LDB(B1, 0, 1); PG8_SCHED; PG8_LDA(At, 0, 0); PG8_STAGE(PG8_SA(1, 1), a1 + hstep, voffA);
            PG8_WAIT_V(8); PG8_WAIT_L(0); PG8_BAR; PG8_MMA(0, 0, At, B0); PG8_MMA(0, 1, At, B1); PG8_BAR; PG8_SCHED;
            PG8_LDA(At, 0, 1); PG8_STAGE(PG8_SB(0, 0), b2, voffB); PG8_STAGE(PG8_SB(0, 1), b2 + hstep, voffB); PG8_STAGE(PG8_SA(0, 0), a2, voffA);
            PG8_WAIT_V(8); PG8_WAIT_L(0); PG8_BAR; PG8_MMA(1, 0, At, B0); PG8_MMA(1, 1, At, B1); PG8_BAR; PG8_SCHED;
            PG8_LDB(B0, 1, 0); PG8_LDB(B1, 1, 1); PG8_SCHED; PG8_LDA(At, 1, 0); PG8_STAGE(PG8_SA(0, 1), a2 + hstep, voffA);
            PG8_WAIT_V(8); PG8_WAIT_L(0); PG8_BAR; PG8_MMA(0, 0, At, B0); PG8_MMA(0, 1, At, B1); PG8_BAR; PG8_SCHED;
            PG8_LDA(At, 1, 1); PG8_STAGE(PG8_SB(1, 0), b3, voffB); PG8_STAGE(PG8_SB(1, 1), b3 + hstep, voffB); PG8_STAGE(PG8_SA(1, 0), a3, voffA);
            PG8_WAIT_V(8); PG8_WAIT_L(0); PG8_BAR; PG8_MMA(1, 0, At, B0); PG8_MMA(1, 1, At, B1); PG8_BAR; PG8_SCHED;
            } else {
            PG8_LDB(B0, 0, 0); PG8_SCHED; PG8_LDA(At, 0, 0); PG8_STAGE(PG8_SA(1, 1), a1 + hstep, voffA);
            PG8_WAIT_L(8); PG8_BAR; PG8_WAIT_L(0); PG8_MMA(0, 0, At, B0); PG8_BAR; PG8_SCHED;
            PG8_LDB(B1, 0, 1); PG8_STAGE(PG8_SB(0, 0), b2, voffB);
            PG8_BAR; PG8_WAIT_L(0); PG8_MMA(0, 1, At, B1); PG8_BAR;
            PG8_LDA(At, 0, 1); PG8_STAGE(PG8_SA(0, 0), a2, voffA);
            PG8_BAR; PG8_WAIT_L(0); PG8_MMA(1, 0, At, B0); PG8_BAR; PG8_SCHED;
            PG8_STAGE(PG8_SB(0, 1), b2 + hstep, voffB);
            PG8_WAIT_V(6); PG8_BAR; PG8_MMA(1, 1, At, B1); PG8_BAR;
            PG8_LDB(B0, 1, 0); PG8_SCHED; PG8_LDA(At, 1, 0); PG8_STAGE(PG8_SA(0, 1), a2 + hstep, voffA);
            PG8_WAIT_L(8); PG8_BAR; PG8_WAIT_L(0); PG8_MMA(0, 0, At, B0); PG8_BAR; PG8_SCHED;
            PG8_LDB(B1, 1, 1); PG8_STAGE(PG8_SB(1, 0), b3, voffB);
            PG8_BAR; PG8_WAIT_L(0); PG8_MMA(0, 1, At, B1); PG8_BAR;
            PG8_LDA(At, 1, 1); PG8_STAGE(PG8_SA(1, 0), a3, voffA);
            PG8_BAR; PG8_WAIT_L(0); PG8_MMA(1, 0, At, B0); PG8_BAR; PG8_SCHED;
            PG8_STAGE(PG8_SB(1, 1), b3 + hstep, voffB);
            PG8_WAIT_V(6); PG8_BAR; PG8_MMA(1, 1, At, B1); PG8_BAR;
            }
        }
        if constexpr (ALIGN_EPI) { if (wr == 0) PG8_BAR; }
        if constexpr (!Epi::AFTER_DRAIN) { E(acc, cur, wr, wc, fr, fq); S.done(cur); }
        if (!has_next) break;
#pragma unroll
        for (int a = 0; a < 2; ++a)
#pragma unroll
            for (int b = 0; b < 2; ++b)
#pragma unroll
                for (int m = 0; m < 4; ++m)
#pragma unroll
                    for (int n = 0; n < 2; ++n) acc[a][b][m][n] = (f32x4){0.f, 0.f, 0.f, 0.f};
        cur = nxt; cA = nA; cB = nB; ++ui;
        if constexpr (ALIGN_EPI) { if (wr == 1) PG8_BAR; }
    }
    PG8_WAIT_V(0);
    if constexpr (!ALIGN_EPI) { if (wr == 0) PG8_BAR; }
    PG8_BAR;
    if constexpr (Epi::AFTER_DRAIN) { E.fused(acc, cur, wr, wc, fr, fq, lds, wid, lane); S.done(cur); }
#undef PG8_SA
#undef PG8_SB
#undef PG8_STAGE
#undef PG8_LDA
#undef PG8_LDB
#undef PG8_MMA
#undef PG8_WAIT_V
#undef PG8_WAIT_L
#undef PG8_BAR
#undef PG8_SCHED
}
}

#define LAS __attribute__((address_space(3)))
#define DI __device__ __forceinline__
struct Ctx { int tid, bid, nb; };
typedef unsigned short bf16;
typedef short bf16x8 __attribute__((ext_vector_type(8)));
typedef float f32x4 __attribute__((ext_vector_type(4)));
typedef float f32x16 __attribute__((ext_vector_type(16)));
typedef unsigned u32x4 __attribute__((ext_vector_type(4)));
typedef unsigned u32x2 __attribute__((ext_vector_type(2)));

constexpr int BATCH = 2, SEQ = 8192, DM = 1024, M = BATCH * SEQ, DEPTH = 4;
constexpr int DIN = 3104, NP = 3072, DFF = 2816, NUP = 5632, NHEAD = 4;
constexpr int OFF_GB = 0, OFF_GC = 512, OFF_GV = 1024, OFF_Q = 1536, OFF_K = 1792, OFF_V = 2048, OFF_GO = 2560;
constexpr float EPS = 1e-6f;
constexpr int NCHUNK = SEQ / 64;
constexpr int PH_PER_LAYER = 10, N_PHASES = DEPTH * PH_PER_LAYER + 1;

constexpr size_t MiB = 1u << 20;
constexpr size_t WS_WIN = 1 * MiB, WS_WOUT = 7 * MiB, WS_WUP = 9 * MiB, WS_WDOWN = 20 * MiB, WS_WLR = 26 * MiB;
constexpr size_t WS_H = 27 * MiB;
constexpr size_t WS_P = 59 * MiB, WS_KV = 155 * MiB, WS_YMIX = 219 * MiB, WS_LR = 251 * MiB, WS_DEC = 253 * MiB;
constexpr size_t WS_Y = 59 * MiB, WS_U = 59 * MiB, WS_G = 235 * MiB, WS_END = 323 * MiB;
constexpr int LDS_BYTES = 136 * 1024;

DI float bf_lo(unsigned w) { return __uint_as_float(w << 16); }
DI float bf_hi(unsigned w) { return __uint_as_float(w & 0xffff0000u); }
DI unsigned f2bf(float f) { unsigned u = __float_as_uint(f); return (u + 0x7fffu + ((u >> 16) & 1u)) >> 16; }
DI unsigned pk2(float lo, float hi) { return f2bf(lo) | (f2bf(hi) << 16); }
DI void unpack8(const u32x4 w, float (&f)[8]) { f[0] = bf_lo(w.x); f[1] = bf_hi(w.x); f[2] = bf_lo(w.y); f[3] = bf_hi(w.y); f[4] = bf_lo(w.z); f[5] = bf_hi(w.z); f[6] = bf_lo(w.w); f[7] = bf_hi(w.w); }
DI u32x4 pack8(const float (&f)[8]) { u32x4 w; w.x = pk2(f[0], f[1]); w.y = pk2(f[2], f[3]); w.z = pk2(f[4], f[5]); w.w = pk2(f[6], f[7]); return w; }
DI float wave_sum(float v) {
#pragma unroll
    for (int o = 1; o < 64; o <<= 1) v += __shfl_xor(v, o);
    return v;
}
DI int crow(int reg, int hh) { return (reg & 3) + 8 * (reg >> 2) + 4 * hh; }
#define MFMA32(a, b, c) __builtin_amdgcn_mfma_f32_32x32x16_bf16((a), (b), (c), 0, 0, 0)
#define LDS_WAIT() asm volatile("s_waitcnt lgkmcnt(0)" ::: "memory")

DI void transpose_item(const float* W, int ldw, int col0, int K, bf16* WT, LAS float* scr, int item, int nblk, int lane) {
    const int kb = item / nblk, nb = item % nblk, k0 = 64 * kb, n0 = 32 * nb;
#pragma unroll 8
    for (int i = 0; i < 32; ++i) { const int kk = 2 * i + (lane >> 5); scr[kk * 33 + (lane & 31)] = W[(size_t)(k0 + kk) * ldw + col0 + n0 + (lane & 31)]; }
    LDS_WAIT(); asm volatile("" ::: "memory");
    const int c = lane & 7;
#pragma unroll
    for (int j = 0; j < 4; ++j) { const int n = (lane >> 3) + 8 * j; const LAS float* s = scr + (8 * c) * 33 + n;
        u32x4 o; o.x = pk2(s[0 * 33], s[1 * 33]); o.y = pk2(s[2 * 33], s[3 * 33]); o.z = pk2(s[4 * 33], s[5 * 33]); o.w = pk2(s[6 * 33], s[7 * 33]);
        *(u32x4*)(WT + (size_t)(n0 + n) * K + k0 + 8 * c) = o; }
    LDS_WAIT(); asm volatile("" ::: "memory");
}
DI void convert_phase(const Ctx cx, const float* w_in, const float* w_out, const float* w_up, const float* w_down, unsigned char* ws, LAS unsigned char* lds) {
    const int lane = cx.tid & 63, wave = cx.tid >> 6;
    LAS float* scr = (LAS float*)(lds + wave * 16384);
    const int gw = cx.bid * 8 + wave, NGW = cx.nb * 8;
    constexpr int I_IN = 16 * 96, I_LR = 16, I_OUT = 16 * 32, I_UP = 16 * 176, I_DOWN = 44 * 32;
    constexpr int NIT = I_IN + I_LR + I_OUT + I_UP + I_DOWN;
    for (int it = gw; it < NIT; it += NGW) {
        int r = it;
        if (r < I_IN) { transpose_item(w_in, DIN, 0, DM, (bf16*)(ws + WS_WIN), scr, r, 96, lane); continue; } r -= I_IN;
        if (r < I_LR) { transpose_item(w_in, DIN, NP, DM, (bf16*)(ws + WS_WLR), scr, r, 1, lane); continue; } r -= I_LR;
        if (r < I_OUT) { transpose_item(w_out, DM, 0, DM, (bf16*)(ws + WS_WOUT), scr, r, 32, lane); continue; } r -= I_OUT;
        if (r < I_UP) { transpose_item(w_up, NUP, 0, DM, (bf16*)(ws + WS_WUP), scr, r, 176, lane); continue; } r -= I_UP;
        transpose_item(w_down, DM, 0, DFF, (bf16*)(ws + WS_WDOWN), scr, r, 32, lane);
    }
}

DI void rows_phase(const Ctx cx, const float* xin, const float* y, const float* gpost, const float* gpre, float* xout, bf16* hout) {
    const int lane = cx.tid & 63, wave = cx.tid >> 6;
    const int gw = cx.bid * 8 + wave, NGW = cx.nb * 8;
    for (int m = gw; m < M; m += NGW) {
        const f32x4* xr = (const f32x4*)(xin + (size_t)m * DM) + lane;
        f32x4 v[4];
#pragma unroll
        for (int j = 0; j < 4; ++j) v[j] = xr[64 * j];
        if (y) {
            const f32x4* yr = (const f32x4*)(y + (size_t)m * DM) + lane;
            f32x4 w[4]; float ss = 0.f;
#pragma unroll
            for (int j = 0; j < 4; ++j) { w[j] = yr[64 * j]; ss += (w[j].x * w[j].x + w[j].y * w[j].y) + (w[j].z * w[j].z + w[j].w * w[j].w); }
            const float r = 1.0f / sqrtf(wave_sum(ss) * (1.0f / DM) + EPS);
#pragma unroll
            for (int j = 0; j < 4; ++j) { const f32x4 g = ((const f32x4*)gpost)[lane + 64 * j]; v[j] = v[j] + w[j] * r * g; }
        }
        if (xout) { f32x4* xo = (f32x4*)(xout + (size_t)m * DM) + lane;
#pragma unroll
            for (int j = 0; j < 4; ++j) xo[64 * j] = v[j]; }
        if (hout) {
            float ss = 0.f;
#pragma unroll
            for (int j = 0; j < 4; ++j) ss += (v[j].x * v[j].x + v[j].y * v[j].y) + (v[j].z * v[j].z + v[j].w * v[j].w);
            const float r = 1.0f / sqrtf(wave_sum(ss) * (1.0f / DM) + EPS);
            u32x2* ho = (u32x2*)(hout + (size_t)m * DM) + lane;
#pragma unroll
            for (int j = 0; j < 4; ++j) { const f32x4 g = ((const f32x4*)gpre)[lane + 64 * j]; const f32x4 o = v[j] * r * g;
                u32x2 w; w.x = pk2(o.x, o.y); w.y = pk2(o.z, o.w); ho[64 * j] = w; }
        }
    }
}

DI void lr_phase(const Ctx cx, const bf16* H, const bf16* WlrT, float* LR, LAS unsigned char* lds) {
    const int tid = cx.tid, lane = tid & 63, wave = tid >> 6, r = lane & 31, hh = lane >> 5;
    LAS float* red = (LAS float*)lds;
    for (int ck = cx.bid; ck < M / 64; ck += cx.nb) {
        f32x16 acc0, acc1;
#pragma unroll
        for (int i = 0; i < 16; ++i) { acc0[i] = 0.f; acc1[i] = 0.f; }
#pragma unroll
        for (int s = 0; s < 8; ++s) { const int k0 = 128 * wave + 16 * s + 8 * hh;
            const bf16x8 b = *(const bf16x8*)(WlrT + (size_t)r * DM + k0);
            const bf16x8 a0 = *(const bf16x8*)(H + (size_t)(64 * ck + r) * DM + k0);
            const bf16x8 a1 = *(const bf16x8*)(H + (size_t)(64 * ck + 32 + r) * DM + k0);
            acc0 = MFMA32(a0, b, acc0); acc1 = MFMA32(a1, b, acc1); }
#pragma unroll
        for (int i = 0; i < 16; ++i) { red[(wave * 64 + crow(i, hh)) * 32 + r] = acc0[i]; red[(wave * 64 + 32 + crow(i, hh)) * 32 + r] = acc1[i]; }
        __syncthreads();
        for (int o = tid; o < 2048; o += 512) { float s = 0.f;
#pragma unroll
            for (int w = 0; w < 8; ++w) s += red[w * 2048 + o];
            LR[(size_t)(64 * ck) * 32 + o] = s; }
        __syncthreads();
    }
}

DI void load_t(const bf16* P, int m, int c, float (&t)[8]) {
    const u32x4 a = *(const u32x4*)(P + (size_t)m * NP + OFF_GC + c), b = *(const u32x4*)(P + (size_t)m * NP + OFF_GV + c);
    float fa[8], fb[8]; unpack8(a, fa); unpack8(b, fb);
#pragma unroll
    for (int j = 0; j < 8; ++j) t[j] = fa[j] * fb[j];
}
DI void conva_phase(const Ctx cx, const bf16* P, const float* cw, bf16* YMIX) {
    const int gt = cx.bid * 512 + cx.tid, NT = cx.nb * 512;
    for (int it = gt; it < (M / 8) * 64; it += NT) {
        const int c = 8 * (it & 63), m0 = 8 * (it >> 6);
        float w0[8], w1[8], w2[8];
#pragma unroll
        for (int j = 0; j < 8; ++j) { w0[j] = cw[c + j]; w1[j] = cw[512 + c + j]; w2[j] = cw[1024 + c + j]; }
        float tp[8], tc[8], tn[8];
        if (m0 % SEQ != 0) load_t(P, m0 - 1, c, tp); else {
#pragma unroll
            for (int j = 0; j < 8; ++j) tp[j] = 0.f; }
        load_t(P, m0, c, tc);
#pragma unroll
        for (int r = 0; r < 8; ++r) { const int m = m0 + r;
            if ((m + 1) % SEQ != 0) load_t(P, m + 1, c, tn); else {
#pragma unroll
                for (int j = 0; j < 8; ++j) tn[j] = 0.f; }
            float gb[8], o[8]; unpack8(*(const u32x4*)(P + (size_t)m * NP + OFF_GB + c), gb);
#pragma unroll
            for (int j = 0; j < 8; ++j) { o[j] = gb[j] * (w0[j] * tp[j] + w1[j] * tc[j] + w2[j] * tn[j]); tp[j] = tc[j]; tc[j] = tn[j]; }
            *(u32x4*)(YMIX + (size_t)m * DM + c) = pack8(o); }
    }
}

DI float logsig16(float x) { return (fminf(x, 0.f) - log1pf(__expf(-fabsf(x)))) * (1.0f / 16.0f); }
DI void gla_gates(const Ctx cx, const float* LR, const float* guf, const float* gbf, const float* gub, const float* gbb, int m0, int h, LAS float* cumF, LAS float* cumB) {
    const int tid = cx.tid, t = tid >> 3, c8 = tid & 7, ch0 = 64 * h + 8 * c8;
    const float* lr = LR + (size_t)(m0 + t) * 32;
    float aF[8], aB[8];
#pragma unroll
    for (int j = 0; j < 8; ++j) { aF[j] = gbf[ch0 + j]; aB[j] = gbb[ch0 + j]; }
#pragma unroll 4
    for (int r = 0; r < 16; ++r) { const float lf = lr[r], lb = lr[16 + r];
        const f32x4 f0 = *(const f32x4*)(guf + r * 256 + ch0), f1 = *(const f32x4*)(guf + r * 256 + ch0 + 4);
        const f32x4 b0 = *(const f32x4*)(gub + r * 256 + ch0), b1 = *(const f32x4*)(gub + r * 256 + ch0 + 4);
#pragma unroll
        for (int j = 0; j < 4; ++j) { aF[j] += lf * f0[j]; aF[4 + j] += lf * f1[j]; aB[j] += lb * b0[j]; aB[4 + j] += lb * b1[j]; } }
#pragma unroll
    for (int j = 0; j < 8; ++j) { cumF[t * 64 + 8 * c8 + j] = logsig16(aF[j]); cumB[t * 64 + 8 * c8 + j] = logsig16(aB[j]); }
    __syncthreads();
    if (tid < 128) { const int ch = tid & 63;
        if (tid < 64) { float s = 0.f;
#pragma unroll 8
            for (int tt = 0; tt < 64; ++tt) { s += cumF[tt * 64 + ch]; cumF[tt * 64 + ch] = s; } }
        else { float s = 0.f;
#pragma unroll 8
            for (int tt = 63; tt >= 0; --tt) { s += cumB[tt * 64 + ch]; cumB[tt * 64 + ch] = s; } } }
    __syncthreads();
}
constexpr int LS = 72;
struct GlaP { const bf16* P; const float* LR; const float *guf, *gbf, *gub, *gbb, *hn; float* KV; float* DEC; bf16* YMIX; };

DI void gla_pass1(const Ctx cx, const GlaP& g, LAS unsigned char* lds) {
    const int tid = cx.tid, lane = tid & 63, wave = tid >> 6, r = lane & 31, hh = lane >> 5;
    LAS float* cumF = (LAS float*)lds; LAS float* cumB = (LAS float*)(lds + 16384);
    LAS bf16* kTf = (LAS bf16*)(lds + 32768); LAS bf16* kTb = kTf + 64 * LS; LAS bf16* vT = kTb + 64 * LS;
    for (int u = cx.bid; u < BATCH * NHEAD * NCHUNK; u += cx.nb) {
        const int bh = u >> 7, c = u & 127, b = bh >> 2, h = bh & 3, m0 = b * SEQ + 64 * c;
        gla_gates(cx, g.LR, g.guf, g.gbf, g.gub, g.gbb, m0, h, cumF, cumB);
        { const int t = tid >> 3, c8 = tid & 7; float kk[8]; unpack8(*(const u32x4*)(g.P + (size_t)(m0 + t) * NP + OFF_K + 64 * h + 8 * c8), kk);
#pragma unroll
          for (int j = 0; j < 8; ++j) { const int d = 8 * c8 + j;
              kTf[d * LS + t] = (bf16)f2bf(kk[j] * __expf(cumF[63 * 64 + d] - cumF[t * 64 + d]));
              kTb[d * LS + t] = (bf16)f2bf(kk[j] * __expf(cumB[d] - cumB[t * 64 + d])); } }
#pragma unroll
        for (int i = 0; i < 2; ++i) { const int idx = tid + 512 * i, t = idx >> 4, c8 = idx & 15;
            const u32x4 vv = *(const u32x4*)(g.P + (size_t)(m0 + t) * NP + OFF_V + 128 * h + 8 * c8);
            const unsigned w[4] = {vv.x, vv.y, vv.z, vv.w};
#pragma unroll
            for (int j = 0; j < 4; ++j) { vT[(8 * c8 + 2 * j) * LS + t] = (bf16)(w[j] & 0xffffu); vT[(8 * c8 + 2 * j + 1) * LS + t] = (bf16)(w[j] >> 16); } }
        __syncthreads();
        { const int dir = wave >> 2, dvt = wave & 3; const LAS bf16* kT = dir ? kTb : kTf;
          f32x16 acc[2];
#pragma unroll
          for (int i = 0; i < 16; ++i) { acc[0][i] = 0.f; acc[1][i] = 0.f; }
#pragma unroll
          for (int ks = 0; ks < 4; ++ks) { const bf16x8 a = *(const LAS bf16x8*)(vT + (32 * dvt + r) * LS + 16 * ks + 8 * hh);
#pragma unroll
              for (int dkt = 0; dkt < 2; ++dkt) { const bf16x8 bb = *(const LAS bf16x8*)(kT + (32 * dkt + r) * LS + 16 * ks + 8 * hh); acc[dkt] = MFMA32(a, bb, acc[dkt]); } }
          float* KVp = g.KV + ((size_t)((bh * 2 + dir) * NCHUNK + c)) * 8192;
#pragma unroll
          for (int dkt = 0; dkt < 2; ++dkt)
#pragma unroll
              for (int i = 0; i < 16; ++i) KVp[(32 * dvt + crow(i, hh)) * 64 + 32 * dkt + r] = acc[dkt][i]; }
        if (tid < 128) { const int dir = tid >> 6, d = tid & 63; g.DEC[((size_t)((bh * 2 + dir) * NCHUNK + c)) * 64 + d] = __expf(dir ? cumB[d] : cumF[63 * 64 + d]); }
        __syncthreads();
    }
}
DI void gla_scan(const Ctx cx, float* KV, const float* DEC) {
    const int gt = cx.bid * 512 + cx.tid, NT = cx.nb * 512;
    for (int e = gt; e < 16 * 8192; e += NT) {
        const int bhd = e >> 13, el = e & 8191, dk = el & 63, dir = bhd & 1;
        float* kv = KV + (size_t)bhd * NCHUNK * 8192 + el; const float* dc = DEC + (size_t)bhd * NCHUNK * 64 + dk;
        float s = 0.f;
        for (int n0 = 0; n0 < NCHUNK; n0 += 8) {
            float x[8], d[8];
#pragma unroll
            for (int i = 0; i < 8; ++i) { const int n = dir ? (NCHUNK - 1 - n0 - i) : (n0 + i); x[i] = kv[(size_t)n * 8192]; d[i] = dc[n * 64]; }
#pragma unroll
            for (int i = 0; i < 8; ++i) { const int n = dir ? (NCHUNK - 1 - n0 - i) : (n0 + i); kv[(size_t)n * 8192] = s; s = d[i] * s + x[i]; }
        }
    }
}
DI void gla_pass3(const Ctx cx, const GlaP& g, LAS unsigned char* lds) {
    const int tid = cx.tid, lane = tid & 63, wave = tid >> 6, r = lane & 31, hh = lane >> 5;
    LAS float* cumF = (LAS float*)lds; LAS float* cumB = (LAS float*)(lds + 16384);
    LAS bf16* qf = (LAS bf16*)(lds + 32768); LAS bf16* kf = qf + 64 * LS; LAS bf16* qb = kf + 64 * LS; LAS bf16* kb = qb + 64 * LS;
    LAS bf16* vT = kb + 64 * LS; LAS bf16* SfT = vT + 128 * LS; LAS bf16* SbT = SfT + 128 * LS; LAS bf16* Sc = SbT + 128 * LS;
    LAS float* part = (LAS float*)(Sc + 64 * LS);
    for (int u = cx.bid; u < BATCH * NHEAD * NCHUNK; u += cx.nb) {
        const int bh = u >> 7, c = u & 127, b = bh >> 2, h = bh & 3, m0 = b * SEQ + 64 * c;
        gla_gates(cx, g.LR, g.guf, g.gbf, g.gub, g.gbb, m0, h, cumF, cumB);
        { const int t = tid >> 3, c8 = tid & 7; float qq[8], kk[8];
          unpack8(*(const u32x4*)(g.P + (size_t)(m0 + t) * NP + OFF_Q + 64 * h + 8 * c8), qq);
          unpack8(*(const u32x4*)(g.P + (size_t)(m0 + t) * NP + OFF_K + 64 * h + 8 * c8), kk);
          float o1[8], o2[8], o3[8], o4[8];
#pragma unroll
          for (int j = 0; j < 8; ++j) { const int d = 8 * c8 + j; const float cf = cumF[t * 64 + d], cb = cumB[t * 64 + d];
              o1[j] = qq[j] * 0.125f * __expf(cf); o2[j] = kk[j] * __expf(-cf); o3[j] = qq[j] * 0.125f * __expf(cb); o4[j] = kk[j] * __expf(-cb); }
          *(LAS u32x4*)(qf + t * LS + 8 * c8) = pack8(o1); *(LAS u32x4*)(kf + t * LS + 8 * c8) = pack8(o2);
          *(LAS u32x4*)(qb + t * LS + 8 * c8) = pack8(o3); *(LAS u32x4*)(kb + t * LS + 8 * c8) = pack8(o4); }
#pragma unroll
        for (int i = 0; i < 2; ++i) { const int idx = tid + 512 * i, t = idx >> 4, c8 = idx & 15;
            const u32x4 vv = *(const u32x4*)(g.P + (size_t)(m0 + t) * NP + OFF_V + 128 * h + 8 * c8);
            const unsigned w[4] = {vv.x, vv.y, vv.z, vv.w};
#pragma unroll
            for (int j = 0; j < 4; ++j) { vT[(8 * c8 + 2 * j) * LS + t] = (bf16)(w[j] & 0xffffu); vT[(8 * c8 + 2 * j + 1) * LS + t] = (bf16)(w[j] >> 16); } }
#pragma unroll
        for (int dir = 0; dir < 2; ++dir) { const float* KVp = g.KV + ((size_t)((bh * 2 + dir) * NCHUNK + c)) * 8192; LAS bf16* ST = dir ? SbT : SfT;
#pragma unroll
            for (int i = 0; i < 4; ++i) { const int e = 4 * (tid + 512 * i), dv = e >> 6, dk = e & 63; const f32x4 s = *(const f32x4*)(KVp + e);
                u32x2 w; w.x = pk2(s.x, s.y); w.y = pk2(s.z, s.w); *(LAS u32x2*)(ST + dv * LS + dk) = w; } }
        __syncthreads();
        if (wave < 4) { const int ti = wave >> 1, tj = wave & 1;
            f32x16 tot;
#pragma unroll
            for (int i = 0; i < 16; ++i) tot[i] = 0.f;
            if (ti >= tj) { f32x16 acc;
#pragma unroll
                for (int i = 0; i < 16; ++i) acc[i] = 0.f;
#pragma unroll
                for (int ks = 0; ks < 4; ++ks) acc = MFMA32(*(const LAS bf16x8*)(qf + (32 * ti + r) * LS + 16 * ks + 8 * hh), *(const LAS bf16x8*)(kf + (32 * tj + r) * LS + 16 * ks + 8 * hh), acc);
#pragma unroll
                for (int i = 0; i < 16; ++i) { const int ii = 32 * ti + crow(i, hh), jj = 32 * tj + r; tot[i] += (jj <= ii) ? acc[i] : 0.f; } }
            if (ti <= tj) { f32x16 acc;
#pragma unroll
                for (int i = 0; i < 16; ++i) acc[i] = 0.f;
#pragma unroll
                for (int ks = 0; ks < 4; ++ks) acc = MFMA32(*(const LAS bf16x8*)(qb + (32 * ti + r) * LS + 16 * ks + 8 * hh), *(const LAS bf16x8*)(kb + (32 * tj + r) * LS + 16 * ks + 8 * hh), acc);
#pragma unroll
                for (int i = 0; i < 16; ++i) { const int ii = 32 * ti + crow(i, hh), jj = 32 * tj + r; tot[i] += (jj >= ii) ? acc[i] : 0.f; } }
#pragma unroll
            for (int i = 0; i < 16; ++i) Sc[(32 * ti + crow(i, hh)) * LS + 32 * tj + r] = (bf16)f2bf(tot[i]);
        }
        __syncthreads();
        { const int ti = wave >> 2, tj = wave & 3;
          f32x16 acc;
#pragma unroll
          for (int i = 0; i < 16; ++i) acc[i] = 0.f;
#pragma unroll
          for (int ks = 0; ks < 4; ++ks) acc = MFMA32(*(const LAS bf16x8*)(Sc + (32 * ti + r) * LS + 16 * ks + 8 * hh), *(const LAS bf16x8*)(vT + (32 * tj + r) * LS + 16 * ks + 8 * hh), acc);
#pragma unroll
          for (int ks = 0; ks < 4; ++ks) acc = MFMA32(*(const LAS bf16x8*)(qf + (32 * ti + r) * LS + 16 * ks + 8 * hh), *(const LAS bf16x8*)(SfT + (32 * tj + r) * LS + 16 * ks + 8 * hh), acc);
#pragma unroll
          for (int ks = 0; ks < 4; ++ks) acc = MFMA32(*(const LAS bf16x8*)(qb + (32 * ti + r) * LS + 16 * ks + 8 * hh), *(const LAS bf16x8*)(SbT + (32 * tj + r) * LS + 16 * ks + 8 * hh), acc);
#pragma unroll
          for (int i = 0; i < 16; ++i) { float s = acc[i] * acc[i];
              s += __shfl_xor(s, 1); s += __shfl_xor(s, 2); s += __shfl_xor(s, 4); s += __shfl_xor(s, 8); s += __shfl_xor(s, 16);
              if (r == 0) part[(32 * ti + crow(i, hh)) * 4 + tj] = s; }
          __syncthreads();
          const int dv = 32 * tj + r; const float gn = g.hn[dv];
#pragma unroll
          for (int i = 0; i < 16; ++i) { const int row = 32 * ti + crow(i, hh);
              const f32x4 ps = *(const LAS f32x4*)(part + row * 4);
              const float rs = 1.0f / sqrtf(((ps.x + ps.y) + (ps.z + ps.w)) * (1.0f / 128.0f) + EPS);
              const float go = __uint_as_float((unsigned)g.P[(size_t)(m0 + row) * NP + OFF_GO + 128 * h + dv] << 16);
              const float sg = go / (1.0f + __expf(-go));
              g.YMIX[(size_t)(m0 + row) * DM + 512 + 128 * h + dv] = (bf16)f2bf(sg * (acc[i] * rs * gn)); } }
        __syncthreads();
    }
}

DI void ffn_conv_phase(const Ctx cx, const bf16* U, const float* cw, bf16* G) {
    const int gt = cx.bid * 512 + cx.tid, NT = cx.nb * 512;
    constexpr int NG = DFF / 8;
    for (int it = gt; it < (M / 16) * NG; it += NT) {
        const int c = 8 * (it % NG), m0 = 16 * (it / NG);
        float wg[3][8], wv[3][8];
#pragma unroll
        for (int k = 0; k < 3; ++k)
#pragma unroll
            for (int j = 0; j < 8; ++j) { wg[k][j] = cw[k * NUP + c + j]; wv[k][j] = cw[k * NUP + DFF + c + j]; }
        float gp[8], gc[8], gn[8], vp[8], vc[8], vn[8];
        if (m0 % SEQ != 0) { unpack8(*(const u32x4*)(U + (size_t)(m0 - 1) * NUP + c), gp); unpack8(*(const u32x4*)(U + (size_t)(m0 - 1) * NUP + DFF + c), vp); }
        else {
#pragma unroll
            for (int j = 0; j < 8; ++j) { gp[j] = 0.f; vp[j] = 0.f; } }
        unpack8(*(const u32x4*)(U + (size_t)m0 * NUP + c), gc); unpack8(*(const u32x4*)(U + (size_t)m0 * NUP + DFF + c), vc);
#pragma unroll 4
        for (int r = 0; r < 16; ++r) { const int m = m0 + r;
            if ((m + 1) % SEQ != 0) { unpack8(*(const u32x4*)(U + (size_t)(m + 1) * NUP + c), gn); unpack8(*(const u32x4*)(U + (size_t)(m + 1) * NUP + DFF + c), vn); }
            else {
#pragma unroll
                for (int j = 0; j < 8; ++j) { gn[j] = 0.f; vn[j] = 0.f; } }
            float o[8];
#pragma unroll
            for (int j = 0; j < 8; ++j) { const float ug = wg[0][j] * gp[j] + wg[1][j] * gc[j] + wg[2][j] * gn[j], uv = wv[0][j] * vp[j] + wv[1][j] * vc[j] + wv[2][j] * vn[j];
                o[j] = ug / (1.0f + __expf(-ug)) * uv; gp[j] = gc[j]; gc[j] = gn[j]; vp[j] = vc[j]; vc[j] = vn[j]; }
            *(u32x4*)(G + (size_t)m * DFF + c) = pack8(o); }
    }
}

#ifndef PHASE_MASK
#define PHASE_MASK 0xffff
#endif
struct Args { const float* in[16]; float* out; unsigned char* ws; int ph_lo, ph_hi; };

template <class Epi> DI void run_gemm(const Ctx cx, LAS unsigned char* lds, const bf16* A, const bf16* Bt, int N, int K, const Epi& E) {
    pg8::Gemm g{A, Bt, M, N, K}; pg8::StaticOrder S; S.init(M, N, (int)cx.nb, (int)cx.bid);
    pg8::gemm_phase<Epi, pg8::StaticOrder, true, true>(cx.tid, lds, g, S, E);
}

__global__ void __launch_bounds__(512, 2) mega(Args a) {
    extern __shared__ __attribute__((aligned(16))) unsigned char lds_raw[];
    LAS unsigned char* lds = (LAS unsigned char*)lds_raw;
    cg::grid_group grid = cg::this_grid();
    unsigned char* ws = a.ws;
    float* X = a.out;
    bf16* H = (bf16*)(ws + WS_H); bf16* P = (bf16*)(ws + WS_P); float* KV = (float*)(ws + WS_KV); bf16* YMIX = (bf16*)(ws + WS_YMIX);
    float* LR = (float*)(ws + WS_LR); float* DEC = (float*)(ws + WS_DEC); float* Y = (float*)(ws + WS_Y); bf16* U = (bf16*)(ws + WS_U); bf16* G = (bf16*)(ws + WS_G);
    for (int p = a.ph_lo; p < a.ph_hi; ++p) {
        const int l = p / PH_PER_LAYER, k = p % PH_PER_LAYER;
        Ctx cx; { int t_ = threadIdx.x, b_ = blockIdx.x, n_ = gridDim.x; asm volatile("" : "+v"(t_)); asm volatile("" : "+s"(b_), "+s"(n_)); cx.tid = t_; cx.bid = b_; cx.nb = n_; }
        if (l == DEPTH) {
#if PHASE_MASK & 1
            rows_phase(cx, X, Y, a.in[4] + (DEPTH - 1) * DM, nullptr, X, nullptr);
#endif
        } else if (k == 0) {
#if PHASE_MASK & 2
            convert_phase(cx, a.in[5] + (size_t)l * DM * DIN, a.in[12] + (size_t)l * DM * DM, a.in[13] + (size_t)l * DM * NUP, a.in[15] + (size_t)l * DFF * DM, ws, lds);
#endif
#if PHASE_MASK & 1
            rows_phase(cx, l == 0 ? a.in[0] : X, l == 0 ? nullptr : Y, a.in[4] + (l > 0 ? l - 1 : 0) * DM, a.in[1] + l * DM, X, H);
#endif
            __syncthreads();
        } else if (k == 1 || k == 7) {
#if PHASE_MASK & 4
            pg8::EpiBf16 E{k == 1 ? P : U, k == 1 ? NP : NUP}; run_gemm(cx, lds, H, (const bf16*)(ws + (k == 1 ? WS_WIN : WS_WUP)), k == 1 ? NP : NUP, DM, E);
#endif
#if PHASE_MASK & 8
            if (k == 1) lr_phase(cx, H, (const bf16*)(ws + WS_WLR), LR, lds);
#endif
        } else if (k == 2 || k == 4) {
            GlaP g{P, LR, a.in[7] + l * 16 * 256, a.in[8] + l * 256, a.in[9] + l * 16 * 256, a.in[10] + l * 256, a.in[11] + l * 128, KV, DEC, YMIX};
            if (k == 2) {
#if PHASE_MASK & 16
                gla_pass1(cx, g, lds);
#endif
#if PHASE_MASK & 32
                conva_phase(cx, P, a.in[6] + l * 3 * 512, YMIX);
#endif
            } else {
#if PHASE_MASK & 64
                gla_pass3(cx, g, lds);
#endif
            }
        } else if (k == 3) {
#if PHASE_MASK & 128
            gla_scan(cx, KV, DEC);
#endif
        } else if (k == 5 || k == 9) {
#if PHASE_MASK & 256
            pg8::EpiF32 E{Y, DM}; run_gemm(cx, lds, k == 5 ? YMIX : G, (const bf16*)(ws + (k == 5 ? WS_WOUT : WS_WDOWN)), DM, k == 5 ? DM : DFF, E);
#endif
        } else if (k == 6) {
#if PHASE_MASK & 1
            rows_phase(cx, X, Y, a.in[2] + l * DM, a.in[3] + l * DM, X, H);
#endif
        } else {
#if PHASE_MASK & 512
            ffn_conv_phase(cx, U, a.in[14] + (size_t)l * 3 * NUP, G);
#endif
        }
        if (p + 1 < a.ph_hi) grid.sync();
    }
}

#ifndef ONE_LAUNCH
#define ONE_LAUNCH 0
#endif
extern "C" void kernel_launch(void* const* d_in, const int* in_sizes, int n_in, void* d_out, int out_size, void* d_ws, size_t ws_size, hipStream_t stream) {
    static int grid = 0;
    if (grid == 0) {
        if (n_in != 16 || out_size != M * DM || ws_size < WS_END) { fprintf(stderr, "kernel_launch: unexpected shapes (n_in %d out %d ws %zu)\n", n_in, out_size, ws_size); grid = -1; return; }
        int dev = 0, cus = 0, per_cu = 0;
        hipGetDevice(&dev); hipDeviceGetAttribute(&cus, hipDeviceAttributeMultiprocessorCount, dev);
        hipFuncSetAttribute((const void*)mega, hipFuncAttributeMaxDynamicSharedMemorySize, LDS_BYTES);
        hipOccupancyMaxActiveBlocksPerMultiprocessor(&per_cu, (const void*)mega, 512, LDS_BYTES);
        if (per_cu < 1) { fprintf(stderr, "kernel_launch: occupancy query says %d\n", per_cu); per_cu = 1; }
        grid = cus * per_cu;
        (void)hipGetLastError();
    }
    if (grid < 0) return;
    Args a{};
    for (int i = 0; i < 16; ++i) a.in[i] = (const float*)d_in[i];
    a.out = (float*)d_out; a.ws = (unsigned char*)d_ws;
#if ONE_LAUNCH
    a.ph_lo = 0; a.ph_hi = N_PHASES;
    void* args[] = {&a};
    hipError_t e = hipLaunchCooperativeKernel((const void*)mega, dim3(grid), dim3(512), args, LDS_BYTES, stream);
    if (e != hipSuccess) fprintf(stderr, "cooperative launch failed: %s (grid %d)\n", hipGetErrorString(e), grid);
#else
    for (int p = 0; p < N_PHASES; ++p) { a.ph_lo = p; a.ph_hi = p + 1; hipLaunchKernelGGL(mega, dim3(grid), dim3(512), LDS_BYTES, stream, a); }
#endif
}
```

```cpp
#include <hip/hip_runtime.h>
#include <hip/hip_cooperative_groups.h>
#include <cstdio>
#include <cstdint>
namespace cg = cooperative_groups;
#define ONE_LAUNCH 1
namespace pg8 {
#define PG8_LAS __attribute__((address_space(3)))
typedef unsigned short bf16_t;
typedef short bf16x8 __attribute__((ext_vector_type(8)));
typedef float f32x4 __attribute__((ext_vector_type(4)));
typedef unsigned u32x4 __attribute__((ext_vector_type(4)));
constexpr int BM = 256, BK = 64, HALF = 128, HTB = HALF * BK * 2  , STAGE_BYTES = 8 * HTB, NXCD = 8, WGM = 8;

__host__ __device__ __forceinline__ int lds_byte(int r, int c) { const int st = (r >> 4) * 2 + (c >> 5), rr = r & 15, cc = c & 31, ob = rr * 64 + cc * 2; return st * 1024 + (ob ^ (((ob >> 9) & 1) << 5)); }
__host__ __device__ __forceinline__ void stage_rc(int b, int& R, int& C) { const int st = b / 1024, sb = b % 1024, swz = sb ^ (((sb >> 9) & 1) << 5); R = (st >> 1) * 16 + swz / 64; C = (st & 1) * 32 + (swz % 64) / 2; }
__host__ __device__ __forceinline__ int perm32(int rho) { const int n = rho >> 4, i = rho & 15; return 8 * (i >> 2) + 4 * n + (i & 3); }

struct Unit { int pm, pn; };
struct Gemm { const bf16_t* A; const bf16_t* Bt; int M, N, K; };

struct StaticOrder {
    int nM, nN, nwg, G, c;
    __host__ __device__ void init(int M, int N, int G_, int c_) { nM = M / BM; nN = N / BM; nwg = nM * nN; G = G_; c = c_; }
    __host__ __device__ bool next(int i, Unit& u) const {
        const long L = (long)i * G + c; if (L >= nwg) return false;
        int wgid = (int)L; { const int q = nwg / NXCD, r = nwg % NXCD, xcd = wgid % NXCD, off = wgid / NXCD; wgid = (xcd < r ? xcd * (q + 1) : r * (q + 1) + (xcd - r) * q) + off; }
        const int nig = WGM * nN, gid = wgid / nig, fm = gid * WGM, gsz = (nM - fm) < WGM ? (nM - fm) : WGM;
        u.pm = fm + ((wgid % nig) % gsz); u.pn = (wgid % nig) / gsz; return true;
    }
    __device__ __forceinline__ void a_ready(const Unit&) const {}
    __device__ __forceinline__ void done(const Unit&) const {}
};

__device__ __forceinline__ unsigned cvt_pk_bf16(float lo, float hi) { unsigned r; asm volatile("v_cvt_pk_bf16_f32 %0, %1, %2" : "=v"(r) : "v"(lo), "v"(hi)); return r; }
typedef unsigned u32x2e __attribute__((ext_vector_type(2)));
struct EpiBf16 {
    static constexpr bool PERM = true, AFTER_DRAIN = false;
    bf16_t* O; int ldc;
    __device__ __forceinline__ void operator()(const f32x4 (&acc)[2][2][4][2], const Unit& u, int wr, int wc, int fr, int fq) const {
        const int row0 = u.pm * BM + wr * 64 + fr; const int col0 = u.pn * BM + wc * 32 + 8 * fq;
#pragma unroll
        for (int ai = 0; ai < 2; ++ai)
#pragma unroll
            for (int m = 0; m < 4; ++m) { bf16_t* rowp = O + (size_t)(row0 + ai * HALF + m * 16) * ldc + col0;
#pragma unroll
                for (int bj = 0; bj < 2; ++bj) { const f32x4 v0 = acc[ai][bj][m][0], v1 = acc[ai][bj][m][1];
                    u32x4 w; w.x = cvt_pk_bf16(v0[0], v0[1]); w.y = cvt_pk_bf16(v0[2], v0[3]); w.z = cvt_pk_bf16(v1[0], v1[1]); w.w = cvt_pk_bf16(v1[2], v1[3]);
                    *(u32x4*)(rowp + bj * HALF) = w; } }
    }
};
struct EpiF32 {
    static constexpr bool PERM = false, AFTER_DRAIN = false;
    float* O; int ldc;
    __device__ __forceinline__ void operator()(const f32x4 (&acc)[2][2][4][2], const Unit& u, int wr, int wc, int fr, int fq) const {
        const int row0 = u.pm * BM + wr * 64 + fr; const int col0 = u.pn * BM + wc * 32 + 4 * fq;
#pragma unroll
        for (int ai = 0; ai < 2; ++ai)
#pragma unroll
            for (int m = 0; m < 4; ++m) { float* rowp = O + (size_t)(row0 + ai * HALF + m * 16) * ldc + col0;
#pragma unroll
                for (int bj = 0; bj < 2; ++bj)
#pragma unroll
                    for (int n = 0; n < 2; ++n) *(f32x4*)(rowp + bj * HALF + n * 16) = acc[ai][bj][m][n]; }
    }
};
template <class Epi, class Sched, bool ALIGN_EPI = false, bool SP2 = false>
__device__ __forceinline__ void gemm_phase(const int tid_in, PG8_LAS unsigned char* lds, const Gemm g, const Sched& S, const Epi& E) {
    const int tid = tid_in, wid = __builtin_amdgcn_readfirstlane(tid >> 6), lane = tid & 63, wr = wid >> 2, wc = wid & 3, fr = lane & 15, fq = lane >> 4;
    const int K = g.K, nt = K / BK;
    unsigned voffA[2], voffB[2];
#pragma unroll
    for (int i = 0; i < 2; ++i) { int R, C; stage_rc(tid * 16 + i * 8192, R, C); const int Rb = Epi::PERM ? ((R & ~31) + perm32(R & 31)) : R;
        voffA[i] = (unsigned)(R * K + C) * 2u; voffB[i] = (unsigned)(Rb * K + C) * 2u; }
    const size_t kstep = (size_t)(BK * 2);
    const size_t hstep = (size_t)HALF * K * 2;
    const size_t tstep = 2 * hstep;
    const unsigned ldsw = (unsigned)wid * 1024u;
    const int aoff = lds_byte(wr * 64 + fr, fq * 8), boff = lds_byte(wc * 32 + fr, fq * 8);
#define PG8_SA(b, h) (((b) * 2 + (h)) * HTB)
#define PG8_SB(b, h) ((4 + (b) * 2 + (h)) * HTB)
#define PG8_STAGE(bufoff, gbase, voff) do { _Pragma("unroll") for (int _i = 0; _i < 2; ++_i) \
        __builtin_amdgcn_global_load_lds((const unsigned*)((const char*)(gbase) + (voff)[_i]), (PG8_LAS unsigned*)(lds + (bufoff) + ldsw + _i * 8192), 16, 0, 0); } while (0)
#define PG8_LDA(dst, b, h) do { _Pragma("unroll") for (int m = 0; m < 4; ++m) _Pragma("unroll") for (int k = 0; k < 2; ++k) dst[m][k] = *(const PG8_LAS bf16x8*)(lds + PG8_SA(b, h) + aoff + m * 2048 + k * 1024); } while (0)
#define PG8_LDB(dst, b, h) do { _Pragma("unroll") for (int n = 0; n < 2; ++n) _Pragma("unroll") for (int k = 0; k < 2; ++k) dst[n][k] = *(const PG8_LAS bf16x8*)(lds + PG8_SB(b, h) + boff + n * 2048 + k * 1024); } while (0)
#define PG8_MMA(ai, bj, At, Bt) do { __builtin_amdgcn_s_setprio(1); _Pragma("unroll") for (int m = 0; m < 4; ++m) _Pragma("unroll") for (int n = 0; n < 2; ++n) _Pragma("unroll") for (int k = 0; k < 2; ++k) \
        acc[ai][bj][m][n] = __builtin_amdgcn_mfma_f32_16x16x32_bf16(Bt[n][k], At[m][k], acc[ai][bj][m][n], 0, 0, 0); __builtin_amdgcn_s_setprio(0); } while (0)
#define PG8_WAIT_V(n) asm volatile("s_waitcnt vmcnt(" #n ")" ::: "memory")
#define PG8_WAIT_L(n) asm volatile("s_waitcnt lgkmcnt(" #n ")" ::: "memory")
#define PG8_BAR __builtin_amdgcn_s_barrier()
#define PG8_SCHED __builtin_amdgcn_sched_barrier(0)
    Unit cur, nxt; int ui = 0;
    if (!S.next(0, cur)) return;
    f32x4 acc[2][2][4][2];
#pragma unroll
    for (int a = 0; a < 2; ++a)
#pragma unroll
        for (int b = 0; b < 2; ++b)
#pragma unroll
            for (int m = 0; m < 4; ++m)
#pragma unroll
                for (int n = 0; n < 2; ++n) acc[a][b][m][n] = (f32x4){0.f, 0.f, 0.f, 0.f};
    bf16x8 At[4][2], B0[2][2], B1[2][2];
    const char* cA = (const char*)g.A + (size_t)cur.pm * tstep; const char* cB = (const char*)g.Bt + (size_t)cur.pn * tstep;
    S.a_ready(cur);
    if constexpr (SP2) {
        PG8_STAGE(PG8_SB(0, 0), cB, voffB); PG8_STAGE(PG8_SB(0, 1), cB + hstep, voffB); PG8_STAGE(PG8_SA(0, 0), cA, voffA); PG8_STAGE(PG8_SA(0, 1), cA + hstep, voffA);
        if (wr == 1) PG8_BAR;
        PG8_WAIT_V(2); PG8_BAR;
        PG8_STAGE(PG8_SB(1, 0), cB + kstep, voffB); PG8_STAGE(PG8_SA(1, 0), cA + kstep, voffA); PG8_STAGE(PG8_SB(1, 1), cB + hstep + kstep, voffB);
        PG8_WAIT_V(6); PG8_BAR;
    } else {
        PG8_STAGE(PG8_SB(0, 0), cB, voffB); PG8_STAGE(PG8_SA(0, 0), cA, voffA); PG8_STAGE(PG8_SB(0, 1), cB + hstep, voffB); PG8_STAGE(PG8_SA(0, 1), cA + hstep, voffA);
        if (wr == 1) PG8_BAR;
        PG8_WAIT_V(4); PG8_BAR;
        PG8_STAGE(PG8_SB(1, 0), cB + kstep, voffB); PG8_STAGE(PG8_SA(1, 0), cA + kstep, voffA); PG8_STAGE(PG8_SB(1, 1), cB + hstep + kstep, voffB);
        PG8_WAIT_V(6); PG8_BAR;
    }
    for (;;) {
        const bool has_next = S.next(ui + 1, nxt);
        const char* nA = has_next ? (const char*)g.A + (size_t)nxt.pm * tstep : cA; const char* nB = has_next ? (const char*)g.Bt + (size_t)nxt.pn * tstep : cB;
        for (int t = 0; t < nt; t += 2) {
            const bool last = (t == nt - 2);
            const char* a1 = cA + (size_t)(t + 1) * kstep;
            const char* a2 = last ? nA : cA + (size_t)(t + 2) * kstep; const char* b2 = last ? nB : cB + (size_t)(t + 2) * kstep;
            const char* a3 = a2 + kstep; const char* b3 = b2 + kstep;
            if (last && has_next) S.a_ready(nxt);
            if constexpr (SP2) {
            PG8_LDB(B0, 0, 0); PG8_LDB(B1, 0, 1); PG8_SCHED; PG8_LDA(At, 0, 0); PG8_STAGE(PG8_SA(1, 1), a1 + hstep, voffA);
            PG8_WAIT_V(8); PG8_WAIT_L(0); PG8_BAR; PG8_MMA(0, 0, At, B0); PG8_MMA(0, 1, At, B1); PG8_BAR; PG8_SCHED;
            PG8_LDA(At, 0, 1); PG8_STAGE(PG8_SB(0, 0), b2, voffB); PG8_STAGE(PG8_SB(0, 1), b2 + hstep, voffB); PG8_STAGE(PG8_SA(0, 0), a2, voffA);
            PG8_WAIT_V(8); PG8_WAIT_L(0); PG8_BAR; PG8_MMA(1, 0, At, B0); PG8_MMA(1, 1, At, B1); PG8_BAR; PG8_SCHED;
            PG8_LDB(B0, 1, 0); PG8_LDB(B1, 1, 1); PG8_SCHED; PG8_LDA(At, 1, 0); PG8_STAGE(PG8_SA(0, 1), a2 + hstep, voffA);
            PG8_WAIT_V(8); PG8_WAIT_L(0); PG8_BAR; PG8_MMA(0, 0, At, B0); PG8_MMA(0, 1, At, B1); PG8_BAR; PG8_SCHED;
            PG8_LDA(At, 1, 1); PG8_STAGE(PG8_SB(1, 0), b3, voffB); PG8_STAGE(PG8_SB(1, 1), b3 + hstep, voffB); PG8_STAGE(PG8_SA(1, 0), a3, voffA);
            PG8_WAIT_V(8); PG8_WAIT_L(0); PG8_BAR; PG8_MMA(1, 0, At, B0); PG8_MMA(1, 1, At, B1); PG8_BAR; PG8_SCHED;
            } else {
            PG8_LDB(B0, 0, 0); PG8_SCHED; PG8_LDA(At, 0, 0); PG8_STAGE(PG8_SA(1, 1), a1 + hstep, voffA);
            PG8_WAIT_L(8); PG8_BAR; PG8_WAIT_L(0); PG8_MMA(0, 0, At, B0); PG8_BAR; PG8_SCHED;
            PG8_LDB(B1, 0, 1); PG8_STAGE(PG8_SB(0, 0), b2, voffB);
            PG8_BAR; PG8_WAIT_L(0); PG8_MMA(0, 1, At, B1); PG8_BAR;
            PG8_LDA(At, 0, 1); PG8_STAGE(PG8_SA(0, 0), a2, voffA);
            PG8_BAR; PG8_WAIT_L(0); PG8_MMA(1, 0, At, B0); PG8_BAR; PG8_SCHED;
            PG8_STAGE(PG8_SB(0, 1), b2 + hstep, voffB);
            PG8_WAIT_V(6); PG8_BAR; PG8_MMA(1, 1, At, B1); PG8_BAR;
            PG8_LDB(B0, 1, 0); PG8_SCHED; PG8_LDA(At, 1, 0); PG8_STAGE(PG8_SA(0, 1), a2 + hstep, voffA);
            PG8_WAIT_L(8); PG8_BAR; PG8_WAIT_L(0); PG8_MMA(0, 0, At, B0); PG8_BAR; PG8_SCHED;
            PG8_LDB(B1, 1, 1); PG8_STAGE(PG8_SB(1, 0), b3, voffB);
            PG8_BAR; PG8_WAIT_L(0); PG8_MMA(0, 1, At, B1); PG8_BAR;
            PG8_LDA(At, 1, 1); PG8_STAGE(PG8_SA(1, 0), a3, voffA);
            PG8_BAR; PG8_WAIT_L(0); PG8_MMA(1, 0, At, B0); PG8_BAR; PG8_SCHED;
            PG8_STAGE(PG8_SB(1, 1), b3 + hstep, voffB);
            PG8_WAIT_V(6); PG8_BAR; PG8_MMA(1, 1, At, B1); PG8_BAR;
            }
        }
        if constexpr (ALIGN_EPI) { if (wr == 0) PG8_BAR; }
        if constexpr (!Epi::AFTER_DRAIN) { E(acc, cur, wr, wc, fr, fq); S.done(cur); }
        if (!has_next) break;
#pragma unroll
        for (int a = 0; a < 2; ++a)
#pragma unroll
            for (int b = 0; b < 2; ++b)
#pragma unroll
                for (int m = 0; m < 4; ++m)
#pragma unroll
                    for (int n = 0; n < 2; ++n) acc[a][b][m][n] = (f32x4){0.f, 0.f, 0.f, 0.f};
        cur = nxt; cA = nA; cB = nB; ++ui;
        if constexpr (ALIGN_EPI) { if (wr == 1) PG8_BAR; }
    }
    PG8_WAIT_V(0);
    if constexpr (!ALIGN_EPI) { if (wr == 0) PG8_BAR; }
    PG8_BAR;
    if constexpr (Epi::AFTER_DRAIN) { E.fused(acc, cur, wr, wc, fr, fq, lds, wid, lane); S.done(cur); }
#undef PG8_SA
#undef PG8_SB
#undef PG8_STAGE
#undef PG8_LDA
#undef PG8_LDB
#undef PG8_MMA
#undef PG8_WAIT_V
#undef PG8_WAIT_L
#undef PG8_BAR
#undef PG8_SCHED
}
}

#define LAS __attribute__((address_space(3)))
#define DI __device__ __forceinline__
struct Ctx { int tid, bid, nb; };
typedef unsigned short bf16;
typedef short bf16x8 __attribute__((ext_vector_type(8)));
typedef float f32x4 __attribute__((ext_vector_type(4)));
typedef float f32x16 __attribute__((ext_vector_type(16)));
typedef unsigned u32x4 __attribute__((ext_vector_type(4)));
typedef unsigned u32x2 __attribute__((ext_vector_type(2)));

constexpr int BATCH = 2, SEQ = 8192, DM = 1024, M = BATCH * SEQ, DEPTH = 4;
constexpr int DIN = 3104, NP = 3072, DFF = 2816, NUP = 5632, NHEAD = 4;
constexpr int OFF_GB = 0, OFF_GC = 512, OFF_GV = 1024, OFF_Q = 1536, OFF_K = 1792, OFF_V = 2048, OFF_GO = 2560;
constexpr float EPS = 1e-6f;
constexpr int NCHUNK = SEQ / 64;
constexpr int PH_PER_LAYER = 10, N_PHASES = DEPTH * PH_PER_LAYER + 1;

constexpr size_t MiB = 1u << 20;
constexpr size_t WS_WIN = 1 * MiB, WS_WOUT = 7 * MiB, WS_WUP = 9 * MiB, WS_WDOWN = 20 * MiB, WS_WLR = 26 * MiB;
constexpr size_t WS_H = 27 * MiB, WS_GUT = 26 * MiB + 65536, WS_SP = 254 * MiB;
constexpr size_t WS_P = 59 * MiB, WS_KV = 155 * MiB, WS_YMIX = 219 * MiB, WS_LR = 251 * MiB, WS_DEC = 253 * MiB;
constexpr size_t WS_Y = 59 * MiB, WS_U = 59 * MiB, WS_G = 235 * MiB, WS_END = 323 * MiB;
constexpr int LDS_BYTES = 150 * 1024;

DI float bf_lo(unsigned w) { return __uint_as_float(w << 16); }
DI float bf_hi(unsigned w) { return __uint_as_float(w & 0xffff0000u); }
DI unsigned f2bf(float f) { unsigned u = __float_as_uint(f); return (u + 0x7fffu + ((u >> 16) & 1u)) >> 16; }
DI unsigned pk2(float lo, float hi) { return f2bf(lo) | (f2bf(hi) << 16); }
DI void unpack8(const u32x4 w, float (&f)[8]) { f[0] = bf_lo(w.x); f[1] = bf_hi(w.x); f[2] = bf_lo(w.y); f[3] = bf_hi(w.y); f[4] = bf_lo(w.z); f[5] = bf_hi(w.z); f[6] = bf_lo(w.w); f[7] = bf_hi(w.w); }
DI u32x4 pack8(const float (&f)[8]) { u32x4 w; w.x = pk2(f[0], f[1]); w.y = pk2(f[2], f[3]); w.z = pk2(f[4], f[5]); w.w = pk2(f[6], f[7]); return w; }
DI float wave_sum(float v) {
#pragma unroll
    for (int o = 1; o < 64; o <<= 1) v += __shfl_xor(v, o);
    return v;
}
DI int crow(int reg, int hh) { return (reg & 3) + 8 * (reg >> 2) + 4 * hh; }
#define MFMA32(a, b, c) __builtin_amdgcn_mfma_f32_32x32x16_bf16((a), (b), (c), 0, 0, 0)
#define LDS_WAIT() asm volatile("s_waitcnt lgkmcnt(0)" ::: "memory")

DI void transpose_item(const float* W, int ldw, int col0, int K, bf16* WT, LAS float* scr, int item, int nblk, int lane) {
    const int kb = item / nblk, nb = item % nblk, k0 = 64 * kb, n0 = 32 * nb;
#pragma unroll 8
    for (int i = 0; i < 32; ++i) { const int kk = 2 * i + (lane >> 5); scr[kk * 33 + (lane & 31)] = W[(size_t)(k0 + kk) * ldw + col0 + n0 + (lane & 31)]; }
    LDS_WAIT(); asm volatile("" ::: "memory");
    const int c = lane & 7;
#pragma unroll
    for (int j = 0; j < 4; ++j) { const int n = (lane >> 3) + 8 * j; const LAS float* s = scr + (8 * c) * 33 + n;
        u32x4 o; o.x = pk2(s[0 * 33], s[1 * 33]); o.y = pk2(s[2 * 33], s[3 * 33]); o.z = pk2(s[4 * 33], s[5 * 33]); o.w = pk2(s[6 * 33], s[7 * 33]);
        *(u32x4*)(WT + (size_t)(n0 + n) * K + k0 + 8 * c) = o; }
    LDS_WAIT(); asm volatile("" ::: "memory");
}
DI void convert_phase(const Ctx cx, const float* w_in, const float* w_out, const float* w_up, const float* w_down, const float* guf, const float* gub, unsigned char* ws, LAS unsigned char* lds) {
    { const int gt = cx.bid * 512 + cx.tid; if (gt < 8192) { const int dir = gt >> 12, ch = (gt >> 4) & 255, rr = gt & 15; ((bf16*)(ws + WS_GUT))[gt] = (bf16)f2bf((dir ? gub : guf)[rr * 256 + ch]); } }
    const int lane = cx.tid & 63, wave = cx.tid >> 6;
    LAS float* scr = (LAS float*)(lds + wave * 16384);
    const int gw = cx.bid * 8 + wave, NGW = cx.nb * 8;
    constexpr int I_IN = 16 * 96, I_LR = 16, I_OUT = 16 * 32, I_UP = 16 * 176, I_DOWN = 44 * 32;
    constexpr int NIT = I_IN + I_LR + I_OUT + I_UP + I_DOWN;
    for (int it = gw; it < NIT; it += NGW) {
        int r = it;
        if (r < I_IN) { transpose_item(w_in, DIN, 0, DM, (bf16*)(ws + WS_WIN), scr, r, 96, lane); continue; } r -= I_IN;
        if (r < I_LR) { transpose_item(w_in, DIN, NP, DM, (bf16*)(ws + WS_WLR), scr, r, 1, lane); continue; } r -= I_LR;
        if (r < I_OUT) { transpose_item(w_out, DM, 0, DM, (bf16*)(ws + WS_WOUT), scr, r, 32, lane); continue; } r -= I_OUT;
        if (r < I_UP) { transpose_item(w_up, NUP, 0, DM, (bf16*)(ws + WS_WUP), scr, r, 176, lane); continue; } r -= I_UP;
        transpose_item(w_down, DM, 0, DFF, (bf16*)(ws + WS_WDOWN), scr, r, 32, lane);
    }
}

DI void rows_phase(const Ctx cx, const float* xin, const float* y, const float* gpost, const float* gpre, float* xout, bf16* hout) {
    const int lane = cx.tid & 63, wave = cx.tid >> 6;
    const int gw = cx.bid * 8 + wave, NGW = cx.nb * 8;
    for (int m = gw; m < M; m += NGW) {
        const f32x4* xr = (const f32x4*)(xin + (size_t)m * DM) + lane;
        f32x4 v[4];
#pragma unroll
        for (int j = 0; j < 4; ++j) v[j] = xr[64 * j];
        if (y) {
            const f32x4* yr = (const f32x4*)(y + (size_t)m * DM) + lane;
            f32x4 w[4]; float ss = 0.f;
#pragma unroll
            for (int j = 0; j < 4; ++j) { w[j] = yr[64 * j]; ss += (w[j].x * w[j].x + w[j].y * w[j].y) + (w[j].z * w[j].z + w[j].w * w[j].w); }
            const float r = 1.0f / sqrtf(wave_sum(ss) * (1.0f / DM) + EPS);
#pragma unroll
            for (int j = 0; j < 4; ++j) { const f32x4 g = ((const f32x4*)gpost)[lane + 64 * j]; v[j] = v[j] + w[j] * r * g; }
        }
        if (xout) { f32x4* xo = (f32x4*)(xout + (size_t)m * DM) + lane;
#pragma unroll
            for (int j = 0; j < 4; ++j) xo[64 * j] = v[j]; }
        if (hout) {
            float ss = 0.f;
#pragma unroll
            for (int j = 0; j < 4; ++j) ss += (v[j].x * v[j].x + v[j].y * v[j].y) + (v[j].z * v[j].z + v[j].w * v[j].w);
            const float r = 1.0f / sqrtf(wave_sum(ss) * (1.0f / DM) + EPS);
            u32x2* ho = (u32x2*)(hout + (size_t)m * DM) + lane;
#pragma unroll
            for (int j = 0; j < 4; ++j) { const f32x4 g = ((const f32x4*)gpre)[lane + 64 * j]; const f32x4 o = v[j] * r * g;
                u32x2 w; w.x = pk2(o.x, o.y); w.y = pk2(o.z, o.w); ho[64 * j] = w; }
        }
    }
}

DI void lr_phase(const Ctx cx, const bf16* H, const bf16* WlrT, bf16* LRB, LAS unsigned char* lds) {
    const int tid = cx.tid, lane = tid & 63, wave = tid >> 6, r = lane & 31, hh = lane >> 5;
    LAS float* red = (LAS float*)lds;
    for (int ck = cx.bid; ck < M / 64; ck += cx.nb) {
        f32x16 acc0, acc1;
#pragma unroll
        for (int i = 0; i < 16; ++i) { acc0[i] = 0.f; acc1[i] = 0.f; }
#pragma unroll
        for (int s = 0; s < 8; ++s) { const int k0 = 128 * wave + 16 * s + 8 * hh;
            const bf16x8 b = *(const bf16x8*)(WlrT + (size_t)r * DM + k0);
            const bf16x8 a0 = *(const bf16x8*)(H + (size_t)(64 * ck + r) * DM + k0);
            const bf16x8 a1 = *(const bf16x8*)(H + (size_t)(64 * ck + 32 + r) * DM + k0);
            acc0 = MFMA32(a0, b, acc0); acc1 = MFMA32(a1, b, acc1); }
#pragma unroll
        for (int i = 0; i < 16; ++i) { red[(wave * 64 + crow(i, hh)) * 32 + r] = acc0[i]; red[(wave * 64 + 32 + crow(i, hh)) * 32 + r] = acc1[i]; }
        __syncthreads();
        for (int o = tid; o < 2048; o += 512) { float s = 0.f;
#pragma unroll
            for (int w = 0; w < 8; ++w) s += red[w * 2048 + o];
            LRB[(size_t)(64 * ck) * 32 + o] = (bf16)f2bf(s); }
        __syncthreads();
    }
}

DI void load_t(const bf16* P, int m, int c, float (&t)[8]) {
    const u32x4 a = *(const u32x4*)(P + (size_t)m * NP + OFF_GC + c), b = *(const u32x4*)(P + (size_t)m * NP + OFF_GV + c);
    float fa[8], fb[8]; unpack8(a, fa); unpack8(b, fb);
#pragma unroll
    for (int j = 0; j < 8; ++j) t[j] = fa[j] * fb[j];
}
DI void conva_phase(const Ctx cx, const bf16* P, const float* cw, bf16* YMIX) {
    const int gt = cx.bid * 512 + cx.tid, NT = cx.nb * 512;
    for (int it = gt; it < (M / 4) * 64; it += NT) {
        const int c = 8 * (it & 63), m0 = 4 * (it >> 6);
        u32x4 gc[6], gv[6], gb[4];
        const bool hasp = (m0 % SEQ) != 0, hasn = ((m0 + 4) % SEQ) != 0;
#pragma unroll
        for (int r = 0; r < 6; ++r) { const int m = m0 - 1 + r; const bool ok = (r == 0) ? hasp : (r == 5 ? hasn : true);
            if (ok) { gc[r] = *(const u32x4*)(P + (size_t)m * NP + OFF_GC + c); gv[r] = *(const u32x4*)(P + (size_t)m * NP + OFF_GV + c); }
            else { gc[r] = (u32x4){0u, 0u, 0u, 0u}; gv[r] = (u32x4){0u, 0u, 0u, 0u}; } }
#pragma unroll
        for (int r = 0; r < 4; ++r) gb[r] = *(const u32x4*)(P + (size_t)(m0 + r) * NP + OFF_GB + c);
        float w0[8], w1[8], w2[8];
#pragma unroll
        for (int j = 0; j < 8; ++j) { w0[j] = cw[c + j]; w1[j] = cw[512 + c + j]; w2[j] = cw[1024 + c + j]; }
        float tt[6][8];
#pragma unroll
        for (int r = 0; r < 6; ++r) { float fa[8], fb[8]; unpack8(gc[r], fa); unpack8(gv[r], fb);
#pragma unroll
            for (int j = 0; j < 8; ++j) tt[r][j] = fa[j] * fb[j]; }
#pragma unroll
        for (int r = 0; r < 4; ++r) { float g8[8], o[8]; unpack8(gb[r], g8);
#pragma unroll
            for (int j = 0; j < 8; ++j) o[j] = g8[j] * (w0[j] * tt[r][j] + w1[j] * tt[r + 1][j] + w2[j] * tt[r + 2][j]);
            *(u32x4*)(YMIX + (size_t)(m0 + r) * DM + c) = pack8(o); }
    }
}

DI float logsig16(float x) { return (fminf(x, 0.f) - __logf(1.0f + __expf(-fabsf(x)))) * (1.0f / 16.0f); }
DI void gla_gates_mfma(int wave, int lane, const bf16* LRB, const bf16* GUT, const float* bias_f, const float* bias_b, int m0, int h, LAS float* cumF, LAS float* cumB) {
    const int r = lane & 31, hh = lane >> 5, dir = wave >> 1, ct = wave & 1, ch = 64 * h + 32 * ct + r;
    const bf16x8 b = *(const bf16x8*)(GUT + ((size_t)(dir * 256 + ch) * 16 + 8 * hh));
    const bf16x8 a0 = *(const bf16x8*)(LRB + (size_t)(m0 + r) * 32 + 16 * dir + 8 * hh);
    const bf16x8 a1 = *(const bf16x8*)(LRB + (size_t)(m0 + 32 + r) * 32 + 16 * dir + 8 * hh);
    const float bias = (dir ? bias_b : bias_f)[ch];
    f32x16 z;
#pragma unroll
    for (int i = 0; i < 16; ++i) z[i] = 0.f;
    f32x16 acc[2]; acc[0] = MFMA32(a0, b, z); acc[1] = MFMA32(a1, b, z);
    LAS float* cum = (dir ? cumB : cumF) + 32 * ct + r;
    float base = 0.f;
    if (dir == 0) {
#pragma unroll
        for (int mt = 0; mt < 2; ++mt)
#pragma unroll
            for (int q = 0; q < 4; ++q) {
                const float p0 = logsig16(acc[mt][4 * q] + bias), p1 = p0 + logsig16(acc[mt][4 * q + 1] + bias), p2 = p1 + logsig16(acc[mt][4 * q + 2] + bias), p3 = p2 + logsig16(acc[mt][4 * q + 3] + bias);
                const float other = __shfl_xor(p3, 32), off = base + (hh ? other : 0.f); const int t0 = 32 * mt + 8 * q + 4 * hh;
                cum[(t0 + 0) * 64] = off + p0; cum[(t0 + 1) * 64] = off + p1; cum[(t0 + 2) * 64] = off + p2; cum[(t0 + 3) * 64] = off + p3;
                base += p3 + other; }
    } else {
#pragma unroll
        for (int mt = 1; mt >= 0; --mt)
#pragma unroll
            for (int q = 3; q >= 0; --q) {
                const float s3 = logsig16(acc[mt][4 * q + 3] + bias), s2 = s3 + logsig16(acc[mt][4 * q + 2] + bias), s1 = s2 + logsig16(acc[mt][4 * q + 1] + bias), s0 = s1 + logsig16(acc[mt][4 * q] + bias);
                const float other = __shfl_xor(s0, 32), off = base + (hh ? 0.f : other); const int t0 = 32 * mt + 8 * q + 4 * hh;
                cum[(t0 + 0) * 64] = off + s0; cum[(t0 + 1) * 64] = off + s1; cum[(t0 + 2) * 64] = off + s2; cum[(t0 + 3) * 64] = off + s3;
                base += s0 + other; }
    }
}
constexpr int LS = 72;
constexpr int OS = 136;
struct GlaP { const bf16* P; const bf16* LRB; const bf16* GUT; const float *gbf, *gbb, *hn; float* KV; float* DEC; bf16* SP; bf16* YMIX; };
DI void write_vT(LAS bf16* vT, const u32x4 vv, int t, int c8) {
    const unsigned w[4] = {vv.x, vv.y, vv.z, vv.w};
#pragma unroll
    for (int j = 0; j < 4; ++j) { vT[(8 * c8 + 2 * j) * LS + t] = (bf16)(w[j] & 0xffffu); vT[(8 * c8 + 2 * j + 1) * LS + t] = (bf16)(w[j] >> 16); }
}

DI void gla_pass1(const Ctx cx, const GlaP& g, LAS unsigned char* lds) {
    const int tid = cx.tid, lane = tid & 63, wave = tid >> 6, r = lane & 31, hh = lane >> 5;
    LAS float* cumF = (LAS float*)lds; LAS float* cumB = (LAS float*)(lds + 16384);
    LAS bf16* kTf = (LAS bf16*)(lds + 32768); LAS bf16* kTb = kTf + 64 * LS; LAS bf16* vT = kTb + 64 * LS;
    for (int u = cx.bid; u < BATCH * NHEAD * NCHUNK; u += cx.nb) {
        const int bh = u >> 7, c = u & 127, b = bh >> 2, h = bh & 3, m0 = b * SEQ + 64 * c;
        const int t = tid >> 3, c8 = tid & 7;
        const u32x4 kraw = *(const u32x4*)(g.P + (size_t)(m0 + t) * NP + OFF_K + 64 * h + 8 * c8);
        const u32x4 v0 = *(const u32x4*)(g.P + (size_t)(m0 + (tid >> 4)) * NP + OFF_V + 128 * h + 8 * (tid & 15));
        const u32x4 v1 = *(const u32x4*)(g.P + (size_t)(m0 + 32 + (tid >> 4)) * NP + OFF_V + 128 * h + 8 * (tid & 15));
        if (wave < 4) gla_gates_mfma(wave, lane, g.LRB, g.GUT, g.gbf, g.gbb, m0, h, cumF, cumB);
        write_vT(vT, v0, tid >> 4, tid & 15); write_vT(vT, v1, 32 + (tid >> 4), tid & 15);
        __syncthreads();
        { float kk[8]; unpack8(kraw, kk);
#pragma unroll
          for (int j = 0; j < 8; ++j) { const int d = 8 * c8 + j;
              kTf[d * LS + t] = (bf16)f2bf(kk[j] * __expf(cumF[63 * 64 + d] - cumF[t * 64 + d]));
              kTb[d * LS + t] = (bf16)f2bf(kk[j] * __expf(cumB[d] - cumB[t * 64 + d])); } }
        __syncthreads();
        { const int dir = wave >> 2, dvt = wave & 3; const LAS bf16* kT = dir ? kTb : kTf;
          f32x16 acc[2];
#pragma unroll
          for (int i = 0; i < 16; ++i) { acc[0][i] = 0.f; acc[1][i] = 0.f; }
#pragma unroll
          for (int ks = 0; ks < 4; ++ks) { const bf16x8 a = *(const LAS bf16x8*)(vT + (32 * dvt + r) * LS + 16 * ks + 8 * hh);
#pragma unroll
              for (int dkt = 0; dkt < 2; ++dkt) { const bf16x8 bb = *(const LAS bf16x8*)(kT + (32 * dkt + r) * LS + 16 * ks + 8 * hh); acc[dkt] = MFMA32(a, bb, acc[dkt]); } }
          float* KVp = g.KV + ((size_t)((bh * 2 + dir) * NCHUNK + c)) * 8192;
#pragma unroll
          for (int dkt = 0; dkt < 2; ++dkt)
#pragma unroll
              for (int i = 0; i < 16; ++i) KVp[(32 * dvt + crow(i, hh)) * 64 + 32 * dkt + r] = acc[dkt][i]; }
        if (tid < 128) { const int dir = tid >> 6, d = tid & 63; g.DEC[((size_t)((bh * 2 + dir) * NCHUNK + c)) * 64 + d] = __expf(dir ? cumB[d] : cumF[63 * 64 + d]); }
        __syncthreads();
    }
}
DI void gla_scan(const Ctx cx, const float* KV, const float* DEC, bf16* SP) {
    const int gt = cx.bid * 512 + cx.tid, NT = cx.nb * 512;
    for (int e = gt; e < 16 * 8192; e += NT) {
        const int bhd = e >> 13, el = e & 8191, dk = el & 63, dir = bhd & 1;
        const float* kv = KV + (size_t)bhd * NCHUNK * 8192 + el; const float* dc = DEC + (size_t)bhd * NCHUNK * 64 + dk; bf16* sp = SP + (size_t)bhd * NCHUNK * 8192 + el;
        float s = 0.f;
        for (int n0 = 0; n0 < NCHUNK; n0 += 16) {
            float x[16], d[16];
#pragma unroll
            for (int i = 0; i < 16; ++i) { const int n = dir ? (NCHUNK - 1 - n0 - i) : (n0 + i); x[i] = kv[(size_t)n * 8192]; d[i] = dc[n * 64]; }
#pragma unroll
            for (int i = 0; i < 16; ++i) { const int n = dir ? (NCHUNK - 1 - n0 - i) : (n0 + i); sp[(size_t)n * 8192] = (bf16)f2bf(s); s = d[i] * s + x[i]; }
        }
    }
}
DI void gla_pass3(const Ctx cx, const GlaP& g, LAS unsigned char* lds) {
    const int tid = cx.tid, lane = tid & 63, wave = tid >> 6, r = lane & 31, hh = lane >> 5;
    LAS float* cumF = (LAS float*)lds; LAS float* cumB = (LAS float*)(lds + 16384);
    LAS bf16* qf = (LAS bf16*)(lds + 32768); LAS bf16* kf = qf + 64 * LS; LAS bf16* qb = kf + 64 * LS; LAS bf16* kb = qb + 64 * LS;
    LAS bf16* vT = kb + 64 * LS; LAS bf16* SfT = vT + 128 * LS; LAS bf16* SbT = SfT + 128 * LS; LAS bf16* Sc = SbT + 128 * LS;
    LAS float* part = (LAS float*)(Sc + 64 * LS);
    LAS bf16* Ost = (LAS bf16*)(part + 256);
    const int t = tid >> 3, c8 = tid & 7;
    float gn[16];
#pragma unroll
    for (int j = 0; j < 16; ++j) gn[j] = g.hn[16 * c8 + j];
    for (int u = cx.bid; u < BATCH * NHEAD * NCHUNK; u += cx.nb) {
        const int bh = u >> 7, c = u & 127, b = bh >> 2, h = bh & 3, m0 = b * SEQ + 64 * c;
        const u32x4 qraw = *(const u32x4*)(g.P + (size_t)(m0 + t) * NP + OFF_Q + 64 * h + 8 * c8);
        const u32x4 kraw = *(const u32x4*)(g.P + (size_t)(m0 + t) * NP + OFF_K + 64 * h + 8 * c8);
        const u32x4 v0 = *(const u32x4*)(g.P + (size_t)(m0 + (tid >> 4)) * NP + OFF_V + 128 * h + 8 * (tid & 15));
        const u32x4 v1 = *(const u32x4*)(g.P + (size_t)(m0 + 32 + (tid >> 4)) * NP + OFF_V + 128 * h + 8 * (tid & 15));
        const bf16* SPf = g.SP + ((size_t)((bh * 2 + 0) * NCHUNK + c)) * 8192; const bf16* SPb = g.SP + ((size_t)((bh * 2 + 1) * NCHUNK + c)) * 8192;
        const u32x4 sf0 = *(const u32x4*)(SPf + 8 * tid), sf1 = *(const u32x4*)(SPf + 8 * (tid + 512));
        const u32x4 sb0 = *(const u32x4*)(SPb + 8 * tid), sb1 = *(const u32x4*)(SPb + 8 * (tid + 512));
        const u32x4 go0 = *(const u32x4*)(g.P + (size_t)(m0 + t) * NP + OFF_GO + 128 * h + 16 * c8), go1 = *(const u32x4*)(g.P + (size_t)(m0 + t) * NP + OFF_GO + 128 * h + 16 * c8 + 8);
        if (wave < 4) gla_gates_mfma(wave, lane, g.LRB, g.GUT, g.gbf, g.gbb, m0, h, cumF, cumB);
        write_vT(vT, v0, tid >> 4, tid & 15); write_vT(vT, v1, 32 + (tid >> 4), tid & 15);
        *(LAS u32x4*)(SfT + (tid >> 3) * LS + 8 * (tid & 7)) = sf0; *(LAS u32x4*)(SfT + (64 + (tid >> 3)) * LS + 8 * (tid & 7)) = sf1;
        *(LAS u32x4*)(SbT + (tid >> 3) * LS + 8 * (tid & 7)) = sb0; *(LAS u32x4*)(SbT + (64 + (tid >> 3)) * LS + 8 * (tid & 7)) = sb1;
        __syncthreads();
        { float qq[8], kk[8]; unpack8(qraw, qq); unpack8(kraw, kk);
          float o1[8], o2[8], o3[8], o4[8];
#pragma unroll
          for (int j = 0; j < 8; ++j) { const int d = 8 * c8 + j; const float cf = cumF[t * 64 + d], cb = cumB[t * 64 + d];
              o1[j] = qq[j] * 0.125f * __expf(cf); o2[j] = kk[j] * __expf(-cf); o3[j] = qq[j] * 0.125f * __expf(cb); o4[j] = kk[j] * __expf(-cb); }
          *(LAS u32x4*)(qf + t * LS + 8 * c8) = pack8(o1); *(LAS u32x4*)(kf + t * LS + 8 * c8) = pack8(o2);
          *(LAS u32x4*)(qb + t * LS + 8 * c8) = pack8(o3); *(LAS u32x4*)(kb + t * LS + 8 * c8) = pack8(o4); }
        __syncthreads();
        if (wave < 4) { const int ti = wave >> 1, tj = wave & 1;
            f32x16 tot;
#pragma unroll
            for (int i = 0; i < 16; ++i) tot[i] = 0.f;
            if (ti >= tj) { f32x16 acc;
#pragma unroll
                for (int i = 0; i < 16; ++i) acc[i] = 0.f;
#pragma unroll
                for (int ks = 0; ks < 4; ++ks) acc = MFMA32(*(const LAS bf16x8*)(qf + (32 * ti + r) * LS + 16 * ks + 8 * hh), *(const LAS bf16x8*)(kf + (32 * tj + r) * LS + 16 * ks + 8 * hh), acc);
#pragma unroll
                for (int i = 0; i < 16; ++i) { const int ii = 32 * ti + crow(i, hh), jj = 32 * tj + r; tot[i] += (jj <= ii) ? acc[i] : 0.f; } }
            if (ti <= tj) { f32x16 acc;
#pragma unroll
                for (int i = 0; i < 16; ++i) acc[i] = 0.f;
#pragma unroll
                for (int ks = 0; ks < 4; ++ks) acc = MFMA32(*(const LAS bf16x8*)(qb + (32 * ti + r) * LS + 16 * ks + 8 * hh), *(const LAS bf16x8*)(kb + (32 * tj + r) * LS + 16 * ks + 8 * hh), acc);
#pragma unroll
                for (int i = 0; i < 16; ++i) { const int ii = 32 * ti + crow(i, hh), jj = 32 * tj + r; tot[i] += (jj >= ii) ? acc[i] : 0.f; } }
#pragma unroll
            for (int i = 0; i < 16; ++i) Sc[(32 * ti + crow(i, hh)) * LS + 32 * tj + r] = (bf16)f2bf(tot[i]);
        }
        __syncthreads();
        { const int ti = wave >> 2, tj = wave & 3;
          f32x16 acc;
#pragma unroll
          for (int i = 0; i < 16; ++i) acc[i] = 0.f;
#pragma unroll
          for (int ks = 0; ks < 4; ++ks) acc = MFMA32(*(const LAS bf16x8*)(Sc + (32 * ti + r) * LS + 16 * ks + 8 * hh), *(const LAS bf16x8*)(vT + (32 * tj + r) * LS + 16 * ks + 8 * hh), acc);
#pragma unroll
          for (int ks = 0; ks < 4; ++ks) acc = MFMA32(*(const LAS bf16x8*)(qf + (32 * ti + r) * LS + 16 * ks + 8 * hh), *(const LAS bf16x8*)(SfT + (32 * tj + r) * LS + 16 * ks + 8 * hh), acc);
#pragma unroll
          for (int ks = 0; ks < 4; ++ks) acc = MFMA32(*(const LAS bf16x8*)(qb + (32 * ti + r) * LS + 16 * ks + 8 * hh), *(const LAS bf16x8*)(SbT + (32 * tj + r) * LS + 16 * ks + 8 * hh), acc);
#pragma unroll
          for (int i = 0; i < 16; ++i) { float s = acc[i] * acc[i];
              s += __shfl_xor(s, 1); s += __shfl_xor(s, 2); s += __shfl_xor(s, 4); s += __shfl_xor(s, 8); s += __shfl_xor(s, 16);
              if (r == 0) part[(32 * ti + crow(i, hh)) * 4 + tj] = s;
              Ost[(32 * ti + crow(i, hh)) * OS + 32 * tj + r] = (bf16)f2bf(acc[i]); } }
        __syncthreads();
        { const f32x4 ps = *(const LAS f32x4*)(part + t * 4);
          const float rs = 1.0f / sqrtf(((ps.x + ps.y) + (ps.z + ps.w)) * (1.0f / 128.0f) + EPS);
          float o[16], gg[16]; unpack8(*(const LAS u32x4*)(Ost + t * OS + 16 * c8), *(float(*)[8])&o[0]); unpack8(*(const LAS u32x4*)(Ost + t * OS + 16 * c8 + 8), *(float(*)[8])&o[8]);
          unpack8(go0, *(float(*)[8])&gg[0]); unpack8(go1, *(float(*)[8])&gg[8]);
          float y[16];
#pragma unroll
          for (int j = 0; j < 16; ++j) y[j] = gg[j] / (1.0f + __expf(-gg[j])) * (o[j] * rs * gn[j]);
          bf16* yp = g.YMIX + (size_t)(m0 + t) * DM + 512 + 128 * h + 16 * c8;
          *(u32x4*)yp = pack8(*(const float(*)[8])&y[0]); *(u32x4*)(yp + 8) = pack8(*(const float(*)[8])&y[8]); }
    }
}

DI void ffn_conv_phase(const Ctx cx, const bf16* U, const float* cw, bf16* G) {
    const int gt = cx.bid * 512 + cx.tid, NT = cx.nb * 512;
    constexpr int NG = DFF / 8;
    for (int it = gt; it < (M / 16) * NG; it += NT) {
        const int c = 8 * (it % NG), m0 = 16 * (it / NG);
        float wg[3][8], wv[3][8];
#pragma unroll
        for (int k = 0; k < 3; ++k)
#pragma unroll
            for (int j = 0; j < 8; ++j) { wg[k][j] = cw[k * NUP + c + j]; wv[k][j] = cw[k * NUP + DFF + c + j]; }
        float gp[8], gc[8], gn[8], vp[8], vc[8], vn[8];
        if (m0 % SEQ != 0) { unpack8(*(const u32x4*)(U + (size_t)(m0 - 1) * NUP + c), gp); unpack8(*(const u32x4*)(U + (size_t)(m0 - 1) * NUP + DFF + c), vp); }
        else {
#pragma unroll
            for (int j = 0; j < 8; ++j) { gp[j] = 0.f; vp[j] = 0.f; } }
        unpack8(*(const u32x4*)(U + (size_t)m0 * NUP + c), gc); unpack8(*(const u32x4*)(U + (size_t)m0 * NUP + DFF + c), vc);
#pragma unroll 4
        for (int r = 0; r < 16; ++r) { const int m = m0 + r;
            if ((m + 1) % SEQ != 0) { unpack8(*(const u32x4*)(U + (size_t)(m + 1) * NUP + c), gn); unpack8(*(const u32x4*)(U + (size_t)(m + 1) * NUP + DFF + c), vn); }
            else {
#pragma unroll
                for (int j = 0; j < 8; ++j) { gn[j] = 0.f; vn[j] = 0.f; } }
            float o[8];
#pragma unroll
            for (int j = 0; j < 8; ++j) { const float ug = wg[0][j] * gp[j] + wg[1][j] * gc[j] + wg[2][j] * gn[j], uv = wv[0][j] * vp[j] + wv[1][j] * vc[j] + wv[2][j] * vn[j];
                o[j] = ug / (1.0f + __expf(-ug)) * uv; gp[j] = gc[j]; gc[j] = gn[j]; vp[j] = vc[j]; vc[j] = vn[j]; }
            *(u32x4*)(G + (size_t)m * DFF + c) = pack8(o); }
    }
}

#ifndef REPEAT_MASK
#define REPEAT_MASK 0
#endif
#ifndef PHASE_MASK
#define PHASE_MASK 0xffff
#endif
struct Args { const float* in[16]; float* out; unsigned char* ws; int ph_lo, ph_hi; };

template <class Epi> DI void run_gemm(const Ctx cx, LAS unsigned char* lds, const bf16* A, const bf16* Bt, int N, int K, const Epi& E) {
    pg8::Gemm g{A, Bt, M, N, K}; pg8::StaticOrder S; S.init(M, N, (int)cx.nb, (int)cx.bid);
    pg8::gemm_phase<Epi, pg8::StaticOrder, true, true>(cx.tid, lds, g, S, E);
}

__global__ void __launch_bounds__(512, 2) mega(Args a) {
    extern __shared__ __attribute__((aligned(16))) unsigned char lds_raw[];
    LAS unsigned char* lds = (LAS unsigned char*)lds_raw;
    cg::grid_group grid = cg::this_grid();
    unsigned char* ws = a.ws;
    float* X = a.out;
    bf16* H = (bf16*)(ws + WS_H); bf16* P = (bf16*)(ws + WS_P); float* KV = (float*)(ws + WS_KV); bf16* YMIX = (bf16*)(ws + WS_YMIX);
    bf16* LRB = (bf16*)(ws + WS_LR); bf16* SP = (bf16*)(ws + WS_SP); const bf16* GUT = (const bf16*)(ws + WS_GUT); float* DEC = (float*)(ws + WS_DEC); float* Y = (float*)(ws + WS_Y); bf16* U = (bf16*)(ws + WS_U); bf16* G = (bf16*)(ws + WS_G);
    for (int p = a.ph_lo; p < a.ph_hi; ++p) {
        const int l = p / PH_PER_LAYER, k = p % PH_PER_LAYER;
        const int nrep = (l < DEPTH && ((REPEAT_MASK >> k) & 1)) ? 2 : 1;
        for (int rep = 0; rep < nrep; ++rep) {
        if (rep) grid.sync();
        Ctx cx; { int t_ = threadIdx.x, b_ = blockIdx.x, n_ = gridDim.x; asm volatile("" : "+v"(t_)); asm volatile("" : "+s"(b_), "+s"(n_)); cx.tid = t_; cx.bid = b_; cx.nb = n_; }
        if (l == DEPTH) {
#if PHASE_MASK & 1
            rows_phase(cx, X, Y, a.in[4] + (DEPTH - 1) * DM, nullptr, X, nullptr);
#endif
        } else if (k == 0) {
#if PHASE_MASK & 2
            convert_phase(cx, a.in[5] + (size_t)l * DM * DIN, a.in[12] + (size_t)l * DM * DM, a.in[13] + (size_t)l * DM * NUP, a.in[15] + (size_t)l * DFF * DM, a.in[7] + l * 16 * 256, a.in[9] + l * 16 * 256, ws, lds);
#endif
#if PHASE_MASK & 1
            rows_phase(cx, l == 0 ? a.in[0] : X, l == 0 ? nullptr : Y, a.in[4] + (l > 0 ? l - 1 : 0) * DM, a.in[1] + l * DM, X, H);
#endif
            __syncthreads();
        } else if (k == 1 || k == 7) {
#if PHASE_MASK & 4
            pg8::EpiBf16 E{k == 1 ? P : U, k == 1 ? NP : NUP}; run_gemm(cx, lds, H, (const bf16*)(ws + (k == 1 ? WS_WIN : WS_WUP)), k == 1 ? NP : NUP, DM, E);
#endif
#if PHASE_MASK & 8
            if (k == 1) lr_phase(cx, H, (const bf16*)(ws + WS_WLR), LRB, lds);
#endif
        } else if (k == 2 || k == 4) {
            GlaP g{P, LRB, GUT, a.in[8] + l * 256, a.in[10] + l * 256, a.in[11] + l * 128, KV, DEC, SP, YMIX};
            if (k == 2) {
#if PHASE_MASK & 16
                gla_pass1(cx, g, lds);
#endif
#if PHASE_MASK & 32
                conva_phase(cx, P, a.in[6] + l * 3 * 512, YMIX);
#endif
            } else {
#if PHASE_MASK & 64
                gla_pass3(cx, g, lds);
#endif
            }
        } else if (k == 3) {
#if PHASE_MASK & 128
            gla_scan(cx, KV, DEC, SP);
#endif
        } else if (k == 5 || k == 9) {
#if PHASE_MASK & 256
            pg8::EpiF32 E{Y, DM}; run_gemm(cx, lds, k == 5 ? YMIX : G, (const bf16*)(ws + (k == 5 ? WS_WOUT : WS_WDOWN)), DM, k == 5 ? DM : DFF, E);
#endif
        } else if (k == 6) {
#if PHASE_MASK & 1
            rows_phase(cx, X, Y, a.in[2] + l * DM, a.in[3] + l * DM, X, H);
#endif
        } else {
#if PHASE_MASK & 512
            ffn_conv_phase(cx, U, a.in[14] + (size_t)l * 3 * NUP, G);
#endif
        }
        }
        if (p + 1 < a.ph_hi) grid.sync();
    }
}

#ifndef ONE_LAUNCH
#define ONE_LAUNCH 0
#endif
extern "C" void kernel_launch(void* const* d_in, const int* in_sizes, int n_in, void* d_out, int out_size, void* d_ws, size_t ws_size, hipStream_t stream) {
    static int grid = 0;
    if (grid == 0) {
        if (n_in != 16 || out_size != M * DM || ws_size < WS_END) { fprintf(stderr, "kernel_launch: unexpected shapes (n_in %d out %d ws %zu)\n", n_in, out_size, ws_size); grid = -1; return; }
        int dev = 0, cus = 0, per_cu = 0;
        hipGetDevice(&dev); hipDeviceGetAttribute(&cus, hipDeviceAttributeMultiprocessorCount, dev);
        hipFuncSetAttribute((const void*)mega, hipFuncAttributeMaxDynamicSharedMemorySize, LDS_BYTES);
        hipOccupancyMaxActiveBlocksPerMultiprocessor(&per_cu, (const void*)mega, 512, LDS_BYTES);
        if (per_cu < 1) { fprintf(stderr, "kernel_launch: occupancy query says %d\n", per_cu); per_cu = 1; }
        grid = cus * per_cu;
        (void)hipGetLastError();
    }
    if (grid < 0) return;
    Args a{};
    for (int i = 0; i < 16; ++i) a.in[i] = (const float*)d_in[i];
    a.out = (float*)d_out; a.ws = (unsigned char*)d_ws;
#if ONE_LAUNCH
    a.ph_lo = 0; a.ph_hi = N_PHASES;
    void* args[] = {&a};
    hipError_t e = hipLaunchCooperativeKernel((const void*)mega, dim3(grid), dim3(512), args, LDS_BYTES, stream);
    if (e != hipSuccess) fprintf(stderr, "cooperative launch failed: %s (grid %d)\n", hipGetErrorString(e), grid);
#else
    for (int p = 0; p < N_PHASES; ++p) { a.ph_lo = p; a.ph_hi = p + 1; hipLaunchKernelGGL(mega, dim3(grid), dim3(512), LDS_BYTES, stream, a); }
#endif
}
```

```cpp
#include <hip/hip_runtime.h>
#include <hip/hip_cooperative_groups.h>
#include <cstdio>
#include <cstdint>
namespace cg = cooperative_groups;
#define ONE_LAUNCH 1
namespace pg8 {
#define PG8_LAS __attribute__((address_space(3)))
typedef unsigned short bf16_t;
typedef short bf16x8 __attribute__((ext_vector_type(8)));
typedef float f32x4 __attribute__((ext_vector_type(4)));
typedef unsigned u32x4 __attribute__((ext_vector_type(4)));
constexpr int BM = 256, BK = 64, HALF = 128, HTB = HALF * BK * 2  , STAGE_BYTES = 8 * HTB, NXCD = 8, WGM = 8;

__host__ __device__ __forceinline__ int lds_byte(int r, int c) { const int st = (r >> 4) * 2 + (c >> 5), rr = r & 15, cc = c & 31, ob = rr * 64 + cc * 2; return st * 1024 + (ob ^ (((ob >> 9) & 1) << 5)); }
__host__ __device__ __forceinline__ void stage_rc(int b, int& R, int& C) { const int st = b / 1024, sb = b % 1024, swz = sb ^ (((sb >> 9) & 1) << 5); R = (st >> 1) * 16 + swz / 64; C = (st & 1) * 32 + (swz % 64) / 2; }
__host__ __device__ __forceinline__ int perm32(int rho) { const int n = rho >> 4, i = rho & 15; return 8 * (i >> 2) + 4 * n + (i & 3); }

struct Unit { int pm, pn; };
struct Gemm { const bf16_t* A; const bf16_t* Bt; int M, N, K; };

struct StaticOrder {
    int nM, nN, nwg, G, c;
    __host__ __device__ void init(int M, int N, int G_, int c_) { nM = M / BM; nN = N / BM; nwg = nM * nN; G = G_; c = c_; }
    __host__ __device__ bool next(int i, Unit& u) const {
        const long L = (long)i * G + c; if (L >= nwg) return false;
        int wgid = (int)L; { const int q = nwg / NXCD, r = nwg % NXCD, xcd = wgid % NXCD, off = wgid / NXCD; wgid = (xcd < r ? xcd * (q + 1) : r * (q + 1) + (xcd - r) * q) + off; }
        const int nig = WGM * nN, gid = wgid / nig, fm = gid * WGM, gsz = (nM - fm) < WGM ? (nM - fm) : WGM;
        u.pm = fm + ((wgid % nig) % gsz); u.pn = (wgid % nig) / gsz; return true;
    }
    __device__ __forceinline__ void a_ready(const Unit&) const {}
    __device__ __forceinline__ void done(const Unit&) const {}
};

typedef float f32x2c __attribute__((ext_vector_type(2)));
typedef __bf16 bf16x2c __attribute__((ext_vector_type(2)));
__device__ __forceinline__ unsigned cvt_pk_bf16(float lo, float hi) { f32x2c f = {lo, hi}; bf16x2c b = __builtin_convertvector(f, bf16x2c); return __builtin_bit_cast(unsigned, b); }
typedef unsigned u32x2e __attribute__((ext_vector_type(2)));
struct EpiBf16 {
    static constexpr bool PERM = true, AFTER_DRAIN = false;
    bf16_t* O; int ldc;
    __device__ __forceinline__ void operator()(const f32x4 (&acc)[2][2][4][2], const Unit& u, int wr, int wc, int fr, int fq) const {
        const int row0 = u.pm * BM + wr * 64 + fr; const int col0 = u.pn * BM + wc * 32 + 8 * fq;
#pragma unroll
        for (int ai = 0; ai < 2; ++ai)
#pragma unroll
            for (int m = 0; m < 4; ++m) { bf16_t* rowp = O + (size_t)(row0 + ai * HALF + m * 16) * ldc + col0;
#pragma unroll
                for (int bj = 0; bj < 2; ++bj) { const f32x4 v0 = acc[ai][bj][m][0], v1 = acc[ai][bj][m][1];
                    u32x4 w; w.x = cvt_pk_bf16(v0[0], v0[1]); w.y = cvt_pk_bf16(v0[2], v0[3]); w.z = cvt_pk_bf16(v1[0], v1[1]); w.w = cvt_pk_bf16(v1[2], v1[3]);
                    *(u32x4*)(rowp + bj * HALF) = w; } }
    }
};
struct EpiF32 {
    static constexpr bool PERM = false, AFTER_DRAIN = false;
    float* O; int ldc;
    __device__ __forceinline__ void operator()(const f32x4 (&acc)[2][2][4][2], const Unit& u, int wr, int wc, int fr, int fq) const {
        const int row0 = u.pm * BM + wr * 64 + fr; const int col0 = u.pn * BM + wc * 32 + 4 * fq;
#pragma unroll
        for (int ai = 0; ai < 2; ++ai)
#pragma unroll
            for (int m = 0; m < 4; ++m) { float* rowp = O + (size_t)(row0 + ai * HALF + m * 16) * ldc + col0;
#pragma unroll
                for (int bj = 0; bj < 2; ++bj)
#pragma unroll
                    for (int n = 0; n < 2; ++n) *(f32x4*)(rowp + bj * HALF + n * 16) = acc[ai][bj][m][n]; }
    }
};
template <class Epi, class Sched, bool ALIGN_EPI = false, bool SP2 = false>
__device__ __forceinline__ void gemm_phase(const int tid_in, PG8_LAS unsigned char* lds, const Gemm g, const Sched& S, const Epi& E) {
    const int tid = tid_in, wid = __builtin_amdgcn_readfirstlane(tid >> 6), lane = tid & 63, wr = wid >> 2, wc = wid & 3, fr = lane & 15, fq = lane >> 4;
    const int K = g.K, nt = K / BK;
    unsigned voffA[2], voffB[2];
#pragma unroll
    for (int i = 0; i < 2; ++i) { int R, C; stage_rc(tid * 16 + i * 8192, R, C); const int Rb = Epi::PERM ? ((R & ~31) + perm32(R & 31)) : R;
        voffA[i] = (unsigned)(R * K + C) * 2u; voffB[i] = (unsigned)(Rb * K + C) * 2u; }
    const size_t kstep = (size_t)(BK * 2);
    const size_t hstep = (size_t)HALF * K * 2;
    const size_t tstep = 2 * hstep;
    const unsigned ldsw = (unsigned)wid * 1024u;
    const int aoff = lds_byte(wr * 64 + fr, fq * 8), boff = lds_byte(wc * 32 + fr, fq * 8);
#define PG8_SA(b, h) (((b) * 2 + (h)) * HTB)
#define PG8_SB(b, h) ((4 + (b) * 2 + (h)) * HTB)
#define PG8_STAGE(bufoff, gbase, voff) do { _Pragma("unroll") for (int _i = 0; _i < 2; ++_i) \
        __builtin_amdgcn_global_load_lds((const unsigned*)((const char*)(gbase) + (voff)[_i]), (PG8_LAS unsigned*)(lds + (bufoff) + ldsw + _i * 8192), 16, 0, 0); } while (0)
#define PG8_LDA(dst, b, h) do { _Pragma("unroll") for (int m = 0; m < 4; ++m) _Pragma("unroll") for (int k = 0; k < 2; ++k) dst[m][k] = *(const PG8_LAS bf16x8*)(lds + PG8_SA(b, h) + aoff + m * 2048 + k * 1024); } while (0)
#define PG8_LDB(dst, b, h) do { _Pragma("unroll") for (int n = 0; n < 2; ++n) _Pragma("unroll") for (int k = 0; k < 2; ++k) dst[n][k] = *(const PG8_LAS bf16x8*)(lds + PG8_SB(b, h) + boff + n * 2048 + k * 1024); } while (0)
#define PG8_MMA(ai, bj, At, Bt) do { __builtin_amdgcn_s_setprio(1); _Pragma("unroll") for (int m = 0; m < 4; ++m) _Pragma("unroll") for (int n = 0; n < 2; ++n) _Pragma("unroll") for (int k = 0; k < 2; ++k) \
        acc[ai][bj][m][n] = __builtin_amdgcn_mfma_f32_16x16x32_bf16(Bt[n][k], At[m][k], acc[ai][bj][m][n], 0, 0, 0); __builtin_amdgcn_s_setprio(0); } while (0)
#define PG8_WAIT_V(n) asm volatile("s_waitcnt vmcnt(" #n ")" ::: "memory")
#define PG8_WAIT_L(n) asm volatile("s_waitcnt lgkmcnt(" #n ")" ::: "memory")
#define PG8_BAR __builtin_amdgcn_s_barrier()
#define PG8_SCHED __builtin_amdgcn_sched_barrier(0)
    Unit cur, nxt; int ui = 0;
    if (!S.next(0, cur)) return;
    f32x4 acc[2][2][4][2];
#pragma unroll
    for (int a = 0; a < 2; ++a)
#pragma unroll
        for (int b = 0; b < 2; ++b)
#pragma unroll
            for (int m = 0; m < 4; ++m)
#pragma unroll
                for (int n = 0; n < 2; ++n) acc[a][b][m][n] = (f32x4){0.f, 0.f, 0.f, 0.f};
    bf16x8 At[4][2], B0[2][2], B1[2][2];
    const char* cA = (const char*)g.A + (size_t)cur.pm * tstep; const char* cB = (const char*)g.Bt + (size_t)cur.pn * tstep;
    S.a_ready(cur);
    if constexpr (SP2) {
        PG8_STAGE(PG8_SB(0, 0), cB, voffB); PG8_STAGE(PG8_SB(0, 1), cB + hstep, voffB); PG8_STAGE(PG8_SA(0, 0), cA, voffA); PG8_STAGE(PG8_SA(0, 1), cA + hstep, voffA);
        if (wr == 1) PG8_BAR;
        PG8_WAIT_V(2); PG8_BAR;
        PG8_STAGE(PG8_SB(1, 0), cB + kstep, voffB); PG8_STAGE(PG8_SA(1, 0), cA + kstep, voffA); PG8_STAGE(PG8_SB(1, 1), cB + hstep + kstep, voffB);
        PG8_WAIT_V(6); PG8_BAR;
    } else {
        PG8_STAGE(PG8_SB(0, 0), cB, voffB); PG8_STAGE(PG8_SA(0, 0), cA, voffA); PG8_STAGE(PG8_SB(0, 1), cB + hstep, voffB); PG8_STAGE(PG8_SA(0, 1), cA + hstep, voffA);
        if (wr == 1) PG8_BAR;
        PG8_WAIT_V(4); PG8_BAR;
        PG8_STAGE(PG8_SB(1, 0), cB + kstep, voffB); PG8_STAGE(PG8_SA(1, 0), cA + kstep, voffA); PG8_STAGE(PG8_SB(1, 1), cB + hstep + kstep, voffB);
        PG8_WAIT_V(6); PG8_BAR;
    }
    for (;;) {
        const bool has_next = S.next(ui + 1, nxt);
        const char* nA = has_next ? (const char*)g.A + (size_t)nxt.pm * tstep : cA; const char* nB = has_next ? (const char*)g.Bt + (size_t)nxt.pn * tstep : cB;
        for (int t = 0; t < nt; t += 2) {
            const bool last = (t == nt - 2);
            const char* a1 = cA + (size_t)(t + 1) * kstep;
            const char* a2 = last ? nA : cA + (size_t)(t + 2) * kstep; const char* b2 = last ? nB : cB + (size_t)(t + 2) * kstep;
            const char* a3 = a2 + kstep; const char* b3 = b2 + kstep;
            if (last && has_next) S.a_ready(nxt);
            if constexpr (SP2) {
            PG8_LDB(B0, 0, 0); PG8_LDB(B1, 0, 1); PG8_SCHED; PG8_LDA(At, 0, 0); PG8_STAGE(PG8_SA(1, 1), a1 + hstep, voffA);
            PG8_WAIT_V(8); PG8_WAIT_L(0); PG8_BAR; PG8_MMA(0, 0, At, B0); PG8_MMA(0, 1, At, B1); PG8_BAR; PG8_SCHED;
            PG8_LDA(At, 0, 1); PG8_STAGE(PG8_SB(0, 0), b2, voffB); PG8_STAGE(PG8_SB(0, 1), b2 + hstep, voffB); PG8_STAGE(PG8_SA(0, 0), a2, voffA);
            PG8_WAIT_V(8); PG8_WAIT_L(0); PG8_BAR; PG8_MMA(1, 0, At, B0); PG8_MMA(1, 1, At, B1); PG8_BAR; PG8_SCHED;
            PG8_LDB(B0, 1, 0); PG8_LDB(B1, 1, 1); PG8_SCHED; PG8_LDA(At, 1, 0); PG8_STAGE(PG8_SA(0, 1), a2 + hstep, voffA);
            PG8_WAIT_V(8); PG8_WAIT_L(0); PG8_BAR; PG8_MMA(0, 0, At, B0); PG8_MMA(0, 1, At, B1); PG8_BAR; PG8_SCHED;
            PG8_LDA(At, 1, 1); PG8_STAGE(PG8_SB(1, 0), b3, voffB); PG8_STAGE(PG8_SB(1, 1), b3 + hstep, voffB); PG8_STAGE(PG8_SA(1, 0), a3, voffA);
            PG8_WAIT_V(8); PG8_WAIT_L(0); PG8_BAR; PG8_MMA(1, 0, At, B0); PG8_MMA(1, 1, At, B1); PG8_BAR; PG8_SCHED;
            } else {
            PG8_LDB(B0, 0, 0); PG8_SCHED; PG8_LDA(At, 0, 0); PG8_STAGE(PG8_SA(1, 1), a1 + hstep, voffA);
            PG8_WAIT_L(8); PG8_BAR; PG8_WAIT_L(0); PG8_MMA(0, 0, At, B0); PG8_BAR; PG8_SCHED;
            PG8_LDB(B1, 0, 1); PG8_STAGE(PG8_SB(0, 0), b2, voffB);
            PG8_BAR; PG8_WAIT_L(0); PG8_MMA(0, 1, At, B1); PG8_BAR;
            PG8_LDA(At, 0, 1); PG8_STAGE(PG8_SA(0, 0), a2, voffA);
            PG8_BAR; PG8_WAIT_L(0); PG8_MMA(1, 0, At, B0); PG8_BAR; PG8_SCHED;
            PG8_STAGE(PG8_SB(0, 1), b2 + hstep, voffB);
            PG8_WAIT_V(6); PG8_BAR; PG8_MMA(1, 1, At, B1); PG8_BAR;
            PG8_LDB(B0, 1, 0); PG8_SCHED; PG8_LDA(At, 1, 0); PG8_STAGE(PG8_SA(0, 1), a2 + hstep, voffA);
            PG8_WAIT_L(8); PG8_BAR; PG8_WAIT_L(0); PG8_MMA(0, 0, At, B0); PG8_BAR; PG8_SCHED;
            PG8_LDB(B1, 1, 1); PG8_STAGE(PG8_SB(1, 0), b3, voffB);
            PG8_BAR; PG8_WAIT_L(0); PG8_MMA(0, 1, At, B1); PG8_BAR;
            PG8_LDA(At, 1, 1); PG8_STAGE(PG8_SA(1, 0), a3, voffA);
            PG8_BAR; PG8_WAIT_L(0); PG8_MMA(1, 0, At, B0); PG8_BAR; PG8_SCHED;
            PG8_STAGE(PG8_SB(1, 1), b3 + hstep, voffB);
            PG8_WAIT_V(6); PG8_BAR; PG8_MMA(1, 1, At, B1); PG8_BAR;
            }
        }
        if constexpr (ALIGN_EPI) { if (wr == 0) PG8_BAR; }
        if constexpr (!Epi::AFTER_DRAIN) { E(acc, cur, wr, wc, fr, fq); S.done(cur); }
        if (!has_next) break;
#pragma unroll
        for (int a = 0; a < 2; ++a)
#pragma unroll
            for (int b = 0; b < 2; ++b)
#pragma unroll
                for (int m = 0; m < 4; ++m)
#pragma unroll
                    for (int n = 0; n < 2; ++n) acc[a][b][m][n] = (f32x4){0.f, 0.f, 0.f, 0.f};
        cur = nxt; cA = nA; cB = nB; ++ui;
        if constexpr (ALIGN_EPI) { if (wr == 1) PG8_BAR; }
    }
    PG8_WAIT_V(0);
    if constexpr (!ALIGN_EPI) { if (wr == 0) PG8_BAR; }
    PG8_BAR;
    if constexpr (Epi::AFTER_DRAIN) { E.fused(acc, cur, wr, wc, fr, fq, lds, wid, lane); S.done(cur); }
#undef PG8_SA
#undef PG8_SB
#undef PG8_STAGE
#undef PG8_LDA
#undef PG8_LDB
#undef PG8_MMA
#undef PG8_WAIT_V
#undef PG8_WAIT_L
#undef PG8_BAR
#undef PG8_SCHED
}
}

#define LAS __attribute__((address_space(3)))
#define DI __device__ __forceinline__
struct Ctx { int tid, bid, nb; };
typedef unsigned short bf16;
typedef short bf16x8 __attribute__((ext_vector_type(8)));
typedef float f32x4 __attribute__((ext_vector_type(4)));
typedef float f32x16 __attribute__((ext_vector_type(16)));
typedef unsigned u32x4 __attribute__((ext_vector_type(4)));
typedef unsigned u32x2 __attribute__((ext_vector_type(2)));

constexpr int BATCH = 2, SEQ = 8192, DM = 1024, M = BATCH * SEQ, DEPTH = 4;
constexpr int DIN = 3104, NP = 3072, DFF = 2816, NUP = 5632, NHEAD = 4;
constexpr int OFF_GB = 0, OFF_GC = 512, OFF_GV = 1024, OFF_Q = 1536, OFF_K = 1792, OFF_V = 2048, OFF_GO = 2560;
constexpr float EPS = 1e-6f;
constexpr int NCHUNK = SEQ / 64;
constexpr int PH_PER_LAYER = 10, N_PHASES = DEPTH * PH_PER_LAYER + 1;

constexpr size_t MiB = 1u << 20;
constexpr size_t WS_WIN = 1 * MiB, WS_WOUT = 7 * MiB, WS_WUP = 9 * MiB, WS_WDOWN = 20 * MiB, WS_WLR = 26 * MiB;
constexpr size_t WS_H = 27 * MiB, WS_GUT = 26 * MiB + 65536, WS_SP = 254 * MiB;
constexpr size_t WS_P = 59 * MiB, WS_KV = 155 * MiB, WS_YMIX = 219 * MiB, WS_LR = 251 * MiB, WS_DEC = 253 * MiB;
constexpr size_t WS_Y = 59 * MiB, WS_U = 59 * MiB, WS_G = 235 * MiB, WS_END = 323 * MiB;
constexpr int LDS_BYTES = 150 * 1024;

DI float bf_lo(unsigned w) { return __uint_as_float(w << 16); }
DI float bf_hi(unsigned w) { return __uint_as_float(w & 0xffff0000u); }
DI unsigned f2bf(float f) { unsigned u = __float_as_uint(f); return (u + 0x7fffu + ((u >> 16) & 1u)) >> 16; }
typedef float f32x2_t __attribute__((ext_vector_type(2)));
typedef __bf16 bf16x2_t __attribute__((ext_vector_type(2)));
DI unsigned pk2(float lo, float hi) { f32x2_t f = {lo, hi}; bf16x2_t b = __builtin_convertvector(f, bf16x2_t); return __builtin_bit_cast(unsigned, b); }
DI void unpack8(const u32x4 w, float (&f)[8]) { f[0] = bf_lo(w.x); f[1] = bf_hi(w.x); f[2] = bf_lo(w.y); f[3] = bf_hi(w.y); f[4] = bf_lo(w.z); f[5] = bf_hi(w.z); f[6] = bf_lo(w.w); f[7] = bf_hi(w.w); }
DI u32x4 pack8(const float (&f)[8]) { u32x4 w; w.x = pk2(f[0], f[1]); w.y = pk2(f[2], f[3]); w.z = pk2(f[4], f[5]); w.w = pk2(f[6], f[7]); return w; }
DI float wave_sum(float v) {
#pragma unroll
    for (int o = 1; o < 64; o <<= 1) v += __shfl_xor(v, o);
    return v;
}
DI int crow(int reg, int hh) { return (reg & 3) + 8 * (reg >> 2) + 4 * hh; }
#define MFMA32(a, b, c) __builtin_amdgcn_mfma_f32_32x32x16_bf16((a), (b), (c), 0, 0, 0)
#define LDS_WAIT() asm volatile("s_waitcnt lgkmcnt(0)" ::: "memory")

DI void transpose_item(const float* W, int ldw, int col0, int K, bf16* WT, LAS float* scr, int item, int nblk, int lane) {
    const int kb = item / nblk, nb = item % nblk, k0 = 64 * kb, n0 = 32 * nb;
#pragma unroll 8
    for (int i = 0; i < 32; ++i) { const int kk = 2 * i + (lane >> 5); scr[kk * 33 + (lane & 31)] = W[(size_t)(k0 + kk) * ldw + col0 + n0 + (lane & 31)]; }
    LDS_WAIT(); asm volatile("" ::: "memory");
    const int c = lane & 7;
#pragma unroll
    for (int j = 0; j < 4; ++j) { const int n = (lane >> 3) + 8 * j; const LAS float* s = scr + (8 * c) * 33 + n;
        u32x4 o; o.x = pk2(s[0 * 33], s[1 * 33]); o.y = pk2(s[2 * 33], s[3 * 33]); o.z = pk2(s[4 * 33], s[5 * 33]); o.w = pk2(s[6 * 33], s[7 * 33]);
        *(u32x4*)(WT + (size_t)(n0 + n) * K + k0 + 8 * c) = o; }
    LDS_WAIT(); asm volatile("" ::: "memory");
}
DI void convert_phase(const Ctx cx, const float* w_in, const float* w_out, const float* w_up, const float* w_down, const float* guf, const float* gub, unsigned char* ws, LAS unsigned char* lds) {
    { const int gt = cx.bid * 512 + cx.tid; if (gt < 8192) { const int dir = gt >> 12, ch = (gt >> 4) & 255, rr = gt & 15; ((bf16*)(ws + WS_GUT))[gt] = (bf16)f2bf((dir ? gub : guf)[rr * 256 + ch]); } }
    const int lane = cx.tid & 63, wave = cx.tid >> 6;
    LAS float* scr = (LAS float*)(lds + wave * 16384);
    const int gw = cx.bid * 8 + wave, NGW = cx.nb * 8;
    constexpr int I_IN = 16 * 96, I_LR = 16, I_OUT = 16 * 32, I_UP = 16 * 176, I_DOWN = 44 * 32;
    constexpr int NIT = I_IN + I_LR + I_OUT + I_UP + I_DOWN;
    for (int it = gw; it < NIT; it += NGW) {
        int r = it;
        if (r < I_IN) { transpose_item(w_in, DIN, 0, DM, (bf16*)(ws + WS_WIN), scr, r, 96, lane); continue; } r -= I_IN;
        if (r < I_LR) { transpose_item(w_in, DIN, NP, DM, (bf16*)(ws + WS_WLR), scr, r, 1, lane); continue; } r -= I_LR;
        if (r < I_OUT) { transpose_item(w_out, DM, 0, DM, (bf16*)(ws + WS_WOUT), scr, r, 32, lane); continue; } r -= I_OUT;
        if (r < I_UP) { transpose_item(w_up, NUP, 0, DM, (bf16*)(ws + WS_WUP), scr, r, 176, lane); continue; } r -= I_UP;
        transpose_item(w_down, DM, 0, DFF, (bf16*)(ws + WS_WDOWN), scr, r, 32, lane);
    }
}

DI void rows_phase(const Ctx cx, const float* xin, const float* y, const float* gpost, const float* gpre, float* xout, bf16* hout) {
    const int lane = cx.tid & 63, wave = cx.tid >> 6;
    const int gw = cx.bid * 8 + wave, NGW = cx.nb * 8;
    for (int mb = gw; mb < M / 2; mb += NGW) {
        f32x4 v[2][4], w[2][4];
#pragma unroll
        for (int q = 0; q < 2; ++q) { const int m = 2 * mb + q; const f32x4* xr = (const f32x4*)(xin + (size_t)m * DM) + lane;
#pragma unroll
            for (int j = 0; j < 4; ++j) v[q][j] = xr[64 * j];
            if (y) { const f32x4* yr = (const f32x4*)(y + (size_t)m * DM) + lane;
#pragma unroll
                for (int j = 0; j < 4; ++j) w[q][j] = yr[64 * j]; } }
#pragma unroll
        for (int q = 0; q < 2; ++q) { const int m = 2 * mb + q;
            if (y) { float ss = 0.f;
#pragma unroll
                for (int j = 0; j < 4; ++j) ss += (w[q][j].x * w[q][j].x + w[q][j].y * w[q][j].y) + (w[q][j].z * w[q][j].z + w[q][j].w * w[q][j].w);
                const float r = 1.0f / sqrtf(wave_sum(ss) * (1.0f / DM) + EPS);
#pragma unroll
                for (int j = 0; j < 4; ++j) { const f32x4 g = ((const f32x4*)gpost)[lane + 64 * j]; v[q][j] = v[q][j] + w[q][j] * r * g; } }
            if (xout) { f32x4* xo = (f32x4*)(xout + (size_t)m * DM) + lane;
#pragma unroll
                for (int j = 0; j < 4; ++j) xo[64 * j] = v[q][j]; }
            if (hout) { float ss = 0.f;
#pragma unroll
                for (int j = 0; j < 4; ++j) ss += (v[q][j].x * v[q][j].x + v[q][j].y * v[q][j].y) + (v[q][j].z * v[q][j].z + v[q][j].w * v[q][j].w);
                const float r = 1.0f / sqrtf(wave_sum(ss) * (1.0f / DM) + EPS);
                u32x2* ho = (u32x2*)(hout + (size_t)m * DM) + lane;
#pragma unroll
                for (int j = 0; j < 4; ++j) { const f32x4 g = ((const f32x4*)gpre)[lane + 64 * j]; const f32x4 o = v[q][j] * r * g;
                    u32x2 ww; ww.x = pk2(o.x, o.y); ww.y = pk2(o.z, o.w); ho[64 * j] = ww; } } }
    }
}

DI void lr_phase(const Ctx cx, const bf16* H, const bf16* WlrT, bf16* LRB, LAS unsigned char* lds) {
    const int tid = cx.tid, lane = tid & 63, wave = tid >> 6, r = lane & 31, hh = lane >> 5;
    LAS float* red = (LAS float*)lds;
    for (int ck = cx.bid; ck < M / 64; ck += cx.nb) {
        f32x16 acc0, acc1;
#pragma unroll
        for (int i = 0; i < 16; ++i) { acc0[i] = 0.f; acc1[i] = 0.f; }
#pragma unroll
        for (int s = 0; s < 8; ++s) { const int k0 = 128 * wave + 16 * s + 8 * hh;
            const bf16x8 b = *(const bf16x8*)(WlrT + (size_t)r * DM + k0);
            const bf16x8 a0 = *(const bf16x8*)(H + (size_t)(64 * ck + r) * DM + k0);
            const bf16x8 a1 = *(const bf16x8*)(H + (size_t)(64 * ck + 32 + r) * DM + k0);
            acc0 = MFMA32(a0, b, acc0); acc1 = MFMA32(a1, b, acc1); }
#pragma unroll
        for (int i = 0; i < 16; ++i) { red[(wave * 64 + crow(i, hh)) * 32 + r] = acc0[i]; red[(wave * 64 + 32 + crow(i, hh)) * 32 + r] = acc1[i]; }
        __syncthreads();
        for (int o = tid; o < 2048; o += 512) { float s = 0.f;
#pragma unroll
            for (int w = 0; w < 8; ++w) s += red[w * 2048 + o];
            LRB[(size_t)(64 * ck) * 32 + o] = (bf16)(pk2(s, s) & 0xffffu); }
        __syncthreads();
    }
}

DI void load_t(const bf16* P, int m, int c, float (&t)[8]) {
    const u32x4 a = *(const u32x4*)(P + (size_t)m * NP + OFF_GC + c), b = *(const u32x4*)(P + (size_t)m * NP + OFF_GV + c);
    float fa[8], fb[8]; unpack8(a, fa); unpack8(b, fb);
#pragma unroll
    for (int j = 0; j < 8; ++j) t[j] = fa[j] * fb[j];
}
DI void conva_phase(const Ctx cx, const bf16* P, const float* cw, bf16* YMIX) {
    const int gt = cx.bid * 512 + cx.tid, NT = cx.nb * 512;
    for (int it = gt; it < (M / 4) * 64; it += NT) {
        const int c = 8 * (it & 63), m0 = 4 * (it >> 6);
        u32x4 gc[6], gv[6], gb[4];
        const bool hasp = (m0 % SEQ) != 0, hasn = ((m0 + 4) % SEQ) != 0;
#pragma unroll
        for (int r = 0; r < 6; ++r) { const int m = m0 - 1 + r; const bool ok = (r == 0) ? hasp : (r == 5 ? hasn : true);
            if (ok) { gc[r] = *(const u32x4*)(P + (size_t)m * NP + OFF_GC + c); gv[r] = *(const u32x4*)(P + (size_t)m * NP + OFF_GV + c); }
            else { gc[r] = (u32x4){0u, 0u, 0u, 0u}; gv[r] = (u32x4){0u, 0u, 0u, 0u}; } }
#pragma unroll
        for (int r = 0; r < 4; ++r) gb[r] = *(const u32x4*)(P + (size_t)(m0 + r) * NP + OFF_GB + c);
        float w0[8], w1[8], w2[8];
#pragma unroll
        for (int j = 0; j < 8; ++j) { w0[j] = cw[c + j]; w1[j] = cw[512 + c + j]; w2[j] = cw[1024 + c + j]; }
        float tt[6][8];
#pragma unroll
        for (int r = 0; r < 6; ++r) { float fa[8], fb[8]; unpack8(gc[r], fa); unpack8(gv[r], fb);
#pragma unroll
            for (int j = 0; j < 8; ++j) tt[r][j] = fa[j] * fb[j]; }
#pragma unroll
        for (int r = 0; r < 4; ++r) { float g8[8], o[8]; unpack8(gb[r], g8);
#pragma unroll
            for (int j = 0; j < 8; ++j) o[j] = g8[j] * (w0[j] * tt[r][j] + w1[j] * tt[r + 1][j] + w2[j] * tt[r + 2][j]);
            *(u32x4*)(YMIX + (size_t)(m0 + r) * DM + c) = pack8(o); }
    }
}

DI float logsig16(float x) { return (fminf(x, 0.f) - __logf(1.0f + __expf(-fabsf(x)))) * (1.0f / 16.0f); }
DI void gla_gates_mfma(int wave, int lane, const bf16* LRB, const bf16* GUT, const float* bias_f, const float* bias_b, int m0, int h, LAS float* cumF, LAS float* cumB) {
    const int r = lane & 31, hh = lane >> 5, dir = wave >> 1, ct = wave & 1, ch = 64 * h + 32 * ct + r;
    const bf16x8 b = *(const bf16x8*)(GUT + ((size_t)(dir * 256 + ch) * 16 + 8 * hh));
    const bf16x8 a0 = *(const bf16x8*)(LRB + (size_t)(m0 + r) * 32 + 16 * dir + 8 * hh);
    const bf16x8 a1 = *(const bf16x8*)(LRB + (size_t)(m0 + 32 + r) * 32 + 16 * dir + 8 * hh);
    const float bias = (dir ? bias_b : bias_f)[ch];
    f32x16 z;
#pragma unroll
    for (int i = 0; i < 16; ++i) z[i] = 0.f;
    f32x16 acc[2]; acc[0] = MFMA32(a0, b, z); acc[1] = MFMA32(a1, b, z);
    LAS float* cum = (dir ? cumB : cumF) + 32 * ct + r;
    float base = 0.f;
    if (dir == 0) {
#pragma unroll
        for (int mt = 0; mt < 2; ++mt)
#pragma unroll
            for (int q = 0; q < 4; ++q) {
                const float p0 = logsig16(acc[mt][4 * q] + bias), p1 = p0 + logsig16(acc[mt][4 * q + 1] + bias), p2 = p1 + logsig16(acc[mt][4 * q + 2] + bias), p3 = p2 + logsig16(acc[mt][4 * q + 3] + bias);
                const float other = __shfl_xor(p3, 32), off = base + (hh ? other : 0.f); const int t0 = 32 * mt + 8 * q + 4 * hh;
                cum[(t0 + 0) * 64] = off + p0; cum[(t0 + 1) * 64] = off + p1; cum[(t0 + 2) * 64] = off + p2; cum[(t0 + 3) * 64] = off + p3;
                base += p3 + other; }
    } else {
#pragma unroll
        for (int mt = 1; mt >= 0; --mt)
#pragma unroll
            for (int q = 3; q >= 0; --q) {
                const float s3 = logsig16(acc[mt][4 * q + 3] + bias), s2 = s3 + logsig16(acc[mt][4 * q + 2] + bias), s1 = s2 + logsig16(acc[mt][4 * q + 1] + bias), s0 = s1 + logsig16(acc[mt][4 * q] + bias);
                const float other = __shfl_xor(s0, 32), off = base + (hh ? 0.f : other); const int t0 = 32 * mt + 8 * q + 4 * hh;
                cum[(t0 + 0) * 64] = off + s0; cum[(t0 + 1) * 64] = off + s1; cum[(t0 + 2) * 64] = off + s2; cum[(t0 + 3) * 64] = off + s3;
                base += s0 + other; }
    }
}
constexpr int LS = 72;
constexpr int OS = 136;
struct GlaP { const bf16* P; const bf16* LRB; const bf16* GUT; const float *gbf, *gbb, *hn; float* KV; float* DEC; bf16* SP; bf16* YMIX; };
DI void write_vT(LAS bf16* vT, const u32x4 vv, int t, int c8) {
    const unsigned w[4] = {vv.x, vv.y, vv.z, vv.w};
#pragma unroll
    for (int j = 0; j < 4; ++j) { vT[(8 * c8 + 2 * j) * LS + t] = (bf16)(w[j] & 0xffffu); vT[(8 * c8 + 2 * j + 1) * LS + t] = (bf16)(w[j] >> 16); }
}

DI void gla_pass1(const Ctx cx, const GlaP& g, LAS unsigned char* lds) {
    const int tid = cx.tid, lane = tid & 63, wave = tid >> 6, r = lane & 31, hh = lane >> 5;
    LAS float* cumF = (LAS float*)lds; LAS float* cumB = (LAS float*)(lds + 16384);
    LAS bf16* kTf = (LAS bf16*)(lds + 32768); LAS bf16* kTb = kTf + 64 * LS; LAS bf16* vT = kTb + 64 * LS;
    for (int u = cx.bid; u < BATCH * NHEAD * NCHUNK; u += cx.nb) {
        const int bh = u >> 7, c = u & 127, b = bh >> 2, h = bh & 3, m0 = b * SEQ + 64 * c;
        const int t = tid >> 3, c8 = tid & 7;
        const u32x4 kraw = *(const u32x4*)(g.P + (size_t)(m0 + t) * NP + OFF_K + 64 * h + 8 * c8);
        const u32x4 v0 = *(const u32x4*)(g.P + (size_t)(m0 + (tid >> 4)) * NP + OFF_V + 128 * h + 8 * (tid & 15));
        const u32x4 v1 = *(const u32x4*)(g.P + (size_t)(m0 + 32 + (tid >> 4)) * NP + OFF_V + 128 * h + 8 * (tid & 15));
        if (wave < 4) gla_gates_mfma(wave, lane, g.LRB, g.GUT, g.gbf, g.gbb, m0, h, cumF, cumB);
        write_vT(vT, v0, tid >> 4, tid & 15); write_vT(vT, v1, 32 + (tid >> 4), tid & 15);
        __syncthreads();
        { float kk[8]; unpack8(kraw, kk);
#pragma unroll
          for (int j = 0; j < 8; j += 2) { const int d = 8 * c8 + j;
              const unsigned pf = pk2(kk[j] * __expf(cumF[63 * 64 + d] - cumF[t * 64 + d]), kk[j + 1] * __expf(cumF[63 * 64 + d + 1] - cumF[t * 64 + d + 1]));
              const unsigned pb = pk2(kk[j] * __expf(cumB[d] - cumB[t * 64 + d]), kk[j + 1] * __expf(cumB[d + 1] - cumB[t * 64 + d + 1]));
              kTf[d * LS + t] = (bf16)(pf & 0xffffu); kTf[(d + 1) * LS + t] = (bf16)(pf >> 16);
              kTb[d * LS + t] = (bf16)(pb & 0xffffu); kTb[(d + 1) * LS + t] = (bf16)(pb >> 16); } }
        __syncthreads();
        { const int dir = wave >> 2, dvt = wave & 3; const LAS bf16* kT = dir ? kTb : kTf;
          f32x16 acc[2];
#pragma unroll
          for (int i = 0; i < 16; ++i) { acc[0][i] = 0.f; acc[1][i] = 0.f; }
#pragma unroll
          for (int ks = 0; ks < 4; ++ks) { const bf16x8 a = *(const LAS bf16x8*)(vT + (32 * dvt + r) * LS + 16 * ks + 8 * hh);
#pragma unroll
              for (int dkt = 0; dkt < 2; ++dkt) { const bf16x8 bb = *(const LAS bf16x8*)(kT + (32 * dkt + r) * LS + 16 * ks + 8 * hh); acc[dkt] = MFMA32(a, bb, acc[dkt]); } }
          float* KVp = g.KV + ((size_t)((bh * 2 + dir) * NCHUNK + c)) * 8192;
#pragma unroll
          for (int dkt = 0; dkt < 2; ++dkt)
#pragma unroll
              for (int i = 0; i < 16; ++i) KVp[(32 * dvt + crow(i, hh)) * 64 + 32 * dkt + r] = acc[dkt][i]; }
        if (tid < 128) { const int dir = tid >> 6, d = tid & 63; g.DEC[((size_t)((bh * 2 + dir) * NCHUNK + c)) * 64 + d] = __expf(dir ? cumB[d] : cumF[63 * 64 + d]); }
        __syncthreads();
    }
}
DI void gla_scan(const Ctx cx, const float* KV, const float* DEC, bf16* SP) {
    const int gt = cx.bid * 512 + cx.tid, NT = cx.nb * 512;
    for (int e = gt; e < 16 * 8192; e += NT) {
        const int bhd = e >> 13, el = e & 8191, dk = el & 63, dir = bhd & 1;
        const float* kv = KV + (size_t)bhd * NCHUNK * 8192 + el; const float* dc = DEC + (size_t)bhd * NCHUNK * 64 + dk; bf16* sp = SP + (size_t)bhd * NCHUNK * 8192 + el;
        float s = 0.f;
        for (int n0 = 0; n0 < NCHUNK; n0 += 16) {
            float x[16], d[16];
#pragma unroll
            for (int i = 0; i < 16; ++i) { const int n = dir ? (NCHUNK - 1 - n0 - i) : (n0 + i); x[i] = kv[(size_t)n * 8192]; d[i] = dc[n * 64]; }
#pragma unroll
            for (int i = 0; i < 16; ++i) { const int n = dir ? (NCHUNK - 1 - n0 - i) : (n0 + i); sp[(size_t)n * 8192] = (bf16)(pk2(s, s) & 0xffffu); s = d[i] * s + x[i]; }
        }
    }
}
DI void gla_pass3(const Ctx cx, const GlaP& g, LAS unsigned char* lds) {
    const int tid = cx.tid, lane = tid & 63, wave = tid >> 6, r = lane & 31, hh = lane >> 5;
    LAS float* cumF = (LAS float*)lds; LAS float* cumB = (LAS float*)(lds + 16384);
    LAS bf16* qf = (LAS bf16*)(lds + 32768); LAS bf16* kf = qf + 64 * LS; LAS bf16* qb = kf + 64 * LS; LAS bf16* kb = qb + 64 * LS;
    LAS bf16* vT = kb + 64 * LS; LAS bf16* SfT = vT + 128 * LS; LAS bf16* SbT = SfT + 128 * LS; LAS bf16* Sc = SbT + 128 * LS;
    LAS float* part = (LAS float*)(Sc + 64 * LS);
    LAS bf16* Ost = (LAS bf16*)(part + 256);
    const int t = tid >> 3, c8 = tid & 7;
    float gn[16];
#pragma unroll
    for (int j = 0; j < 16; ++j) gn[j] = g.hn[16 * c8 + j];
    for (int u = cx.bid; u < BATCH * NHEAD * NCHUNK; u += cx.nb) {
        const int bh = u >> 7, c = u & 127, b = bh >> 2, h = bh & 3, m0 = b * SEQ + 64 * c;
        const u32x4 qraw = *(const u32x4*)(g.P + (size_t)(m0 + t) * NP + OFF_Q + 64 * h + 8 * c8);
        const u32x4 kraw = *(const u32x4*)(g.P + (size_t)(m0 + t) * NP + OFF_K + 64 * h + 8 * c8);
        const u32x4 v0 = *(const u32x4*)(g.P + (size_t)(m0 + (tid >> 4)) * NP + OFF_V + 128 * h + 8 * (tid & 15));
        const u32x4 v1 = *(const u32x4*)(g.P + (size_t)(m0 + 32 + (tid >> 4)) * NP + OFF_V + 128 * h + 8 * (tid & 15));
        const bf16* SPf = g.SP + ((size_t)((bh * 2 + 0) * NCHUNK + c)) * 8192; const bf16* SPb = g.SP + ((size_t)((bh * 2 + 1) * NCHUNK + c)) * 8192;
        const u32x4 sf0 = *(const u32x4*)(SPf + 8 * tid), sf1 = *(const u32x4*)(SPf + 8 * (tid + 512));
        const u32x4 sb0 = *(const u32x4*)(SPb + 8 * tid), sb1 = *(const u32x4*)(SPb + 8 * (tid + 512));
        const u32x4 go0 = *(const u32x4*)(g.P + (size_t)(m0 + t) * NP + OFF_GO + 128 * h + 16 * c8), go1 = *(const u32x4*)(g.P + (size_t)(m0 + t) * NP + OFF_GO + 128 * h + 16 * c8 + 8);
        if (wave < 4) gla_gates_mfma(wave, lane, g.LRB, g.GUT, g.gbf, g.gbb, m0, h, cumF, cumB);
        write_vT(vT, v0, tid >> 4, tid & 15); write_vT(vT, v1, 32 + (tid >> 4), tid & 15);
        *(LAS u32x4*)(SfT + (tid >> 3) * LS + 8 * (tid & 7)) = sf0; *(LAS u32x4*)(SfT + (64 + (tid >> 3)) * LS + 8 * (tid & 7)) = sf1;
        *(LAS u32x4*)(SbT + (tid >> 3) * LS + 8 * (tid & 7)) = sb0; *(LAS u32x4*)(SbT + (64 + (tid >> 3)) * LS + 8 * (tid & 7)) = sb1;
        __syncthreads();
        { float qq[8], kk[8]; unpack8(qraw, qq); unpack8(kraw, kk);
          float o1[8], o2[8], o3[8], o4[8];
#pragma unroll
          for (int j = 0; j < 8; ++j) { const int d = 8 * c8 + j; const float cf = cumF[t * 64 + d], cb = cumB[t * 64 + d];
              o1[j] = qq[j] * 0.125f * __expf(cf); o2[j] = kk[j] * __expf(-cf); o3[j] = qq[j] * 0.125f * __expf(cb); o4[j] = kk[j] * __expf(-cb); }
          *(LAS u32x4*)(qf + t * LS + 8 * c8) = pack8(o1); *(LAS u32x4*)(kf + t * LS + 8 * c8) = pack8(o2);
          *(LAS u32x4*)(qb + t * LS + 8 * c8) = pack8(o3); *(LAS u32x4*)(kb + t * LS + 8 * c8) = pack8(o4); }
        __syncthreads();
        if (wave < 4) { const int ti = wave >> 1, tj = wave & 1;
            f32x16 tot;
#pragma unroll
            for (int i = 0; i < 16; ++i) tot[i] = 0.f;
            if (ti >= tj) { f32x16 acc;
#pragma unroll
                for (int i = 0; i < 16; ++i) acc[i] = 0.f;
#pragma unroll
                for (int ks = 0; ks < 4; ++ks) acc = MFMA32(*(const LAS bf16x8*)(qf + (32 * ti + r) * LS + 16 * ks + 8 * hh), *(const LAS bf16x8*)(kf + (32 * tj + r) * LS + 16 * ks + 8 * hh), acc);
#pragma unroll
                for (int i = 0; i < 16; ++i) { const int ii = 32 * ti + crow(i, hh), jj = 32 * tj + r; tot[i] += (jj <= ii) ? acc[i] : 0.f; } }
            if (ti <= tj) { f32x16 acc;
#pragma unroll
                for (int i = 0; i < 16; ++i) acc[i] = 0.f;
#pragma unroll
                for (int ks = 0; ks < 4; ++ks) acc = MFMA32(*(const LAS bf16x8*)(qb + (32 * ti + r) * LS + 16 * ks + 8 * hh), *(const LAS bf16x8*)(kb + (32 * tj + r) * LS + 16 * ks + 8 * hh), acc);
#pragma unroll
                for (int i = 0; i < 16; ++i) { const int ii = 32 * ti + crow(i, hh), jj = 32 * tj + r; tot[i] += (jj >= ii) ? acc[i] : 0.f; } }
#pragma unroll
            for (int i = 0; i < 16; ++i) Sc[(32 * ti + crow(i, hh)) * LS + 32 * tj + r] = (bf16)(pk2(tot[i], tot[i]) & 0xffffu);
        }
        __syncthreads();
        { const int ti = wave >> 2, tj = wave & 3;
          f32x16 acc;
#pragma unroll
          for (int i = 0; i < 16; ++i) acc[i] = 0.f;
#pragma unroll
          for (int ks = 0; ks < 4; ++ks) acc = MFMA32(*(const LAS bf16x8*)(Sc + (32 * ti + r) * LS + 16 * ks + 8 * hh), *(const LAS bf16x8*)(vT + (32 * tj + r) * LS + 16 * ks + 8 * hh), acc);
#pragma unroll
          for (int ks = 0; ks < 4; ++ks) acc = MFMA32(*(const LAS bf16x8*)(qf + (32 * ti + r) * LS + 16 * ks + 8 * hh), *(const LAS bf16x8*)(SfT + (32 * tj + r) * LS + 16 * ks + 8 * hh), acc);
#pragma unroll
          for (int ks = 0; ks < 4; ++ks) acc = MFMA32(*(const LAS bf16x8*)(qb + (32 * ti + r) * LS + 16 * ks + 8 * hh), *(const LAS bf16x8*)(SbT + (32 * tj + r) * LS + 16 * ks + 8 * hh), acc);
#pragma unroll
          for (int i = 0; i < 16; ++i) Ost[(32 * ti + crow(i, hh)) * OS + 32 * tj + r] = (bf16)(pk2(acc[i], acc[i]) & 0xffffu); }
        __syncthreads();
        { float o[16], gg[16]; unpack8(*(const LAS u32x4*)(Ost + t * OS + 16 * c8), *(float(*)[8])&o[0]); unpack8(*(const LAS u32x4*)(Ost + t * OS + 16 * c8 + 8), *(float(*)[8])&o[8]);
          float ss = 0.f;
#pragma unroll
          for (int j = 0; j < 16; ++j) ss += o[j] * o[j];
          ss += __shfl_xor(ss, 1); ss += __shfl_xor(ss, 2); ss += __shfl_xor(ss, 4);
          const float rs = 1.0f / sqrtf(ss * (1.0f / 128.0f) + EPS);
          unpack8(go0, *(float(*)[8])&gg[0]); unpack8(go1, *(float(*)[8])&gg[8]);
          float y[16];
#pragma unroll
          for (int j = 0; j < 16; ++j) y[j] = gg[j] / (1.0f + __expf(-gg[j])) * (o[j] * rs * gn[j]);
          bf16* yp = g.YMIX + (size_t)(m0 + t) * DM + 512 + 128 * h + 16 * c8;
          *(u32x4*)yp = pack8(*(const float(*)[8])&y[0]); *(u32x4*)(yp + 8) = pack8(*(const float(*)[8])&y[8]); }
    }
}

DI void ffn_conv_phase(const Ctx cx, const bf16* U, const float* cw, bf16* G) {
    const int gt = cx.bid * 512 + cx.tid, NT = cx.nb * 512;
    constexpr int NG = DFF / 8, RB = 8;
    for (int it = gt; it < (M / RB) * NG; it += NT) {
        const int c = 8 * (it % NG), m0 = RB * (it / NG);
        u32x4 ug[RB + 2], uv[RB + 2];
        const bool hasp = (m0 % SEQ) != 0, hasn = ((m0 + RB) % SEQ) != 0;
#pragma unroll
        for (int r = 0; r < RB + 2; ++r) { const int m = m0 - 1 + r; const bool ok = (r == 0) ? hasp : (r == RB + 1 ? hasn : true);
            if (ok) { ug[r] = *(const u32x4*)(U + (size_t)m * NUP + c); uv[r] = *(const u32x4*)(U + (size_t)m * NUP + DFF + c); }
            else { ug[r] = (u32x4){0u, 0u, 0u, 0u}; uv[r] = (u32x4){0u, 0u, 0u, 0u}; } }
        float wg[3][8], wv[3][8];
#pragma unroll
        for (int k = 0; k < 3; ++k)
#pragma unroll
            for (int j = 0; j < 8; ++j) { wg[k][j] = cw[k * NUP + c + j]; wv[k][j] = cw[k * NUP + DFF + c + j]; }
        float gp[8], gc[8], gn[8], vp[8], vc[8], vn[8];
        unpack8(ug[0], gp); unpack8(uv[0], vp); unpack8(ug[1], gc); unpack8(uv[1], vc);
#pragma unroll
        for (int r = 0; r < RB; ++r) { unpack8(ug[r + 2], gn); unpack8(uv[r + 2], vn);
            float o[8];
#pragma unroll
            for (int j = 0; j < 8; ++j) { const float a = wg[0][j] * gp[j] + wg[1][j] * gc[j] + wg[2][j] * gn[j], bq = wv[0][j] * vp[j] + wv[1][j] * vc[j] + wv[2][j] * vn[j];
                o[j] = a / (1.0f + __expf(-a)) * bq; gp[j] = gc[j]; gc[j] = gn[j]; vp[j] = vc[j]; vc[j] = vn[j]; }
            *(u32x4*)(G + (size_t)(m0 + r) * DFF + c) = pack8(o); }
    }
}

#ifndef REPEAT_MASK
#define REPEAT_MASK 0
#endif
#ifndef PHASE_MASK
#define PHASE_MASK 0xffff
#endif
struct Args { const float* in[16]; float* out; unsigned char* ws; int ph_lo, ph_hi; };

template <class Epi> DI void run_gemm(const Ctx cx, LAS unsigned char* lds, const bf16* A, const bf16* Bt, int N, int K, const Epi& E) {
    pg8::Gemm g{A, Bt, M, N, K}; pg8::StaticOrder S; S.init(M, N, (int)cx.nb, (int)cx.bid);
    pg8::gemm_phase<Epi, pg8::StaticOrder, true, true>(cx.tid, lds, g, S, E);
}

__global__ void __launch_bounds__(512, 2) mega(Args a) {
    extern __shared__ __attribute__((aligned(16))) unsigned char lds_raw[];
    LAS unsigned char* lds = (LAS unsigned char*)lds_raw;
    cg::grid_group grid = cg::this_grid();
    unsigned char* ws = a.ws;
    float* X = a.out;
    bf16* H = (bf16*)(ws + WS_H); bf16* P = (bf16*)(ws + WS_P); float* KV = (float*)(ws + WS_KV); bf16* YMIX = (bf16*)(ws + WS_YMIX);
    bf16* LRB = (bf16*)(ws + WS_LR); bf16* SP = (bf16*)(ws + WS_SP); const bf16* GUT = (const bf16*)(ws + WS_GUT); float* DEC = (float*)(ws + WS_DEC); float* Y = (float*)(ws + WS_Y); bf16* U = (bf16*)(ws + WS_U); bf16* G = (bf16*)(ws + WS_G);
    for (int p = a.ph_lo; p < a.ph_hi; ++p) {
        const int l = p / PH_PER_LAYER, k = p % PH_PER_LAYER;
        const int nrep = (l < DEPTH && ((REPEAT_MASK >> k) & 1)) ? 2 : 1;
        for (int rep = 0; rep < nrep; ++rep) {
        if (rep) grid.sync();
        Ctx cx; { int t_ = threadIdx.x, b_ = blockIdx.x, n_ = gridDim.x; asm volatile("" : "+v"(t_)); asm volatile("" : "+s"(b_), "+s"(n_)); cx.tid = t_; cx.bid = b_; cx.nb = n_; }
        if (l == DEPTH) {
#if PHASE_MASK & 1
            rows_phase(cx, X, Y, a.in[4] + (DEPTH - 1) * DM, nullptr, X, nullptr);
#endif
        } else if (k == 0) {
#if PHASE_MASK & 2
            convert_phase(cx, a.in[5] + (size_t)l * DM * DIN, a.in[12] + (size_t)l * DM * DM, a.in[13] + (size_t)l * DM * NUP, a.in[15] + (size_t)l * DFF * DM, a.in[7] + l * 16 * 256, a.in[9] + l * 16 * 256, ws, lds);
#endif
#if PHASE_MASK & 1
            rows_phase(cx, l == 0 ? a.in[0] : X, l == 0 ? nullptr : Y, a.in[4] + (l > 0 ? l - 1 : 0) * DM, a.in[1] + l * DM, X, H);
#endif
            __syncthreads();
        } else if (k == 1 || k == 7) {
#if PHASE_MASK & 4
            pg8::EpiBf16 E{k == 1 ? P : U, k == 1 ? NP : NUP}; run_gemm(cx, lds, H, (const bf16*)(ws + (k == 1 ? WS_WIN : WS_WUP)), k == 1 ? NP : NUP, DM, E);
#endif
#if PHASE_MASK & 8
            if (k == 1) lr_phase(cx, H, (const bf16*)(ws + WS_WLR), LRB, lds);
#endif
        } else if (k == 2 || k == 4) {
            GlaP g{P, LRB, GUT, a.in[8] + l * 256, a.in[10] + l * 256, a.in[11] + l * 128, KV, DEC, SP, YMIX};
            if (k == 2) {
#if PHASE_MASK & 16
                gla_pass1(cx, g, lds);
#endif
#if PHASE_MASK & 32
                conva_phase(cx, P, a.in[6] + l * 3 * 512, YMIX);
#endif
            } else {
#if PHASE_MASK & 64
                gla_pass3(cx, g, lds);
#endif
            }
        } else if (k == 3) {
#if PHASE_MASK & 128
            gla_scan(cx, KV, DEC, SP);
#endif
        } else if (k == 5 || k == 9) {
#if PHASE_MASK & 256
            pg8::EpiF32 E{Y, DM}; run_gemm(cx, lds, k == 5 ? YMIX : G, (const bf16*)(ws + (k == 5 ? WS_WOUT : WS_WDOWN)), DM, k == 5 ? DM : DFF, E);
#endif
        } else if (k == 6) {
#if PHASE_MASK & 1
            rows_phase(cx, X, Y, a.in[2] + l * DM, a.in[3] + l * DM, X, H);
#endif
        } else {
#if PHASE_MASK & 512
            ffn_conv_phase(cx, U, a.in[14] + (size_t)l * 3 * NUP, G);
#endif
        }
        }
        if (p + 1 < a.ph_hi) grid.sync();
    }
}

#ifndef ONE_LAUNCH
#define ONE_LAUNCH 0
#endif
extern "C" void kernel_launch(void* const* d_in, const int* in_sizes, int n_in, void* d_out, int out_size, void* d_ws, size_t ws_size, hipStream_t stream) {
    static int grid = 0;
    if (grid == 0) {
        if (n_in != 16 || out_size != M * DM || ws_size < WS_END) { fprintf(stderr, "kernel_launch: unexpected shapes (n_in %d out %d ws %zu)\n", n_in, out_size, ws_size); grid = -1; return; }
        int dev = 0, cus = 0, per_cu = 0;
        hipGetDevice(&dev); hipDeviceGetAttribute(&cus, hipDeviceAttributeMultiprocessorCount, dev);
        hipFuncSetAttribute((const void*)mega, hipFuncAttributeMaxDynamicSharedMemorySize, LDS_BYTES);
        hipOccupancyMaxActiveBlocksPerMultiprocessor(&per_cu, (const void*)mega, 512, LDS_BYTES);
        if (per_cu < 1) { fprintf(stderr, "kernel_launch: occupancy query says %d\n", per_cu); per_cu = 1; }
        grid = cus * per_cu;
        (void)hipGetLastError();
    }
    if (grid < 0) return;
    Args a{};
    for (int i = 0; i < 16; ++i) a.in[i] = (const float*)d_in[i];
    a.out = (float*)d_out; a.ws = (unsigned char*)d_ws;
#if ONE_LAUNCH
    a.ph_lo = 0; a.ph_hi = N_PHASES;
    void* args[] = {&a};
    hipError_t e = hipLaunchCooperativeKernel((const void*)mega, dim3(grid), dim3(512), args, LDS_BYTES, stream);
    if (e != hipSuccess) fprintf(stderr, "cooperative launch failed: %s (grid %d)\n", hipGetErrorString(e), grid);
#else
    for (int p = 0; p < N_PHASES; ++p) { a.ph_lo = p; a.ph_hi = p + 1; hipLaunchKernelGGL(mega, dim3(grid), dim3(512), LDS_BYTES, stream, a); }
#endif
}
```

```cpp
#include <hip/hip_runtime.h>
#include <hip/hip_cooperative_groups.h>
#include <cstdio>
#include <cstdint>
namespace cg = cooperative_groups;
#define ONE_LAUNCH 1
namespace pg8 {
#define PG8_LAS __attribute__((address_space(3)))
typedef unsigned short bf16_t;
typedef short bf16x8 __attribute__((ext_vector_type(8)));
typedef float f32x4 __attribute__((ext_vector_type(4)));
typedef unsigned u32x4 __attribute__((ext_vector_type(4)));
constexpr int BM = 256, BK = 64, HALF = 128, HTB = HALF * BK * 2  , STAGE_BYTES = 8 * HTB, NXCD = 8, WGM = 8;

__host__ __device__ __forceinline__ int lds_byte(int r, int c) { const int st = (r >> 4) * 2 + (c >> 5), rr = r & 15, cc = c & 31, ob = rr * 64 + cc * 2; return st * 1024 + (ob ^ (((ob >> 9) & 1) << 5)); }
__host__ __device__ __forceinline__ void stage_rc(int b, int& R, int& C) { const int st = b / 1024, sb = b % 1024, swz = sb ^ (((sb >> 9) & 1) << 5); R = (st >> 1) * 16 + swz / 64; C = (st & 1) * 32 + (swz % 64) / 2; }
__host__ __device__ __forceinline__ int perm32(int rho) { const int n = rho >> 4, i = rho & 15; return 8 * (i >> 2) + 4 * n + (i & 3); }

struct Unit { int pm, pn; };
struct Gemm { const bf16_t* A; const bf16_t* Bt; int M, N, K; };

struct StaticOrder {
    int nM, nN, nwg, G, c;
    __host__ __device__ void init(int M, int N, int G_, int c_) { nM = M / BM; nN = N / BM; nwg = nM * nN; G = G_; c = c_; }
    __host__ __device__ bool next(int i, Unit& u) const {
        const long L = (long)i * G + c; if (L >= nwg) return false;
        int wgid = (int)L; { const int q = nwg / NXCD, r = nwg % NXCD, xcd = wgid % NXCD, off = wgid / NXCD; wgid = (xcd < r ? xcd * (q + 1) : r * (q + 1) + (xcd - r) * q) + off; }
        const int nig = WGM * nN, gid = wgid / nig, fm = gid * WGM, gsz = (nM - fm) < WGM ? (nM - fm) : WGM;
        u.pm = fm + ((wgid % nig) % gsz); u.pn = (wgid % nig) / gsz; return true;
    }
    __device__ __forceinline__ void a_ready(const Unit&) const {}
    __device__ __forceinline__ void done(const Unit&) const {}
};

typedef float f32x2c __attribute__((ext_vector_type(2)));
typedef __bf16 bf16x2c __attribute__((ext_vector_type(2)));
__device__ __forceinline__ unsigned cvt_pk_bf16(float lo, float hi) { f32x2c f = {lo, hi}; bf16x2c b = __builtin_convertvector(f, bf16x2c); return __builtin_bit_cast(unsigned, b); }
typedef unsigned u32x2e __attribute__((ext_vector_type(2)));
struct EpiBf16 {
    static constexpr bool PERM = true, AFTER_DRAIN = false;
    bf16_t* O; int ldc;
    __device__ __forceinline__ void operator()(const f32x4 (&acc)[2][2][4][2], const Unit& u, int wr, int wc, int fr, int fq) const {
        const int row0 = u.pm * BM + wr * 64 + fr; const int col0 = u.pn * BM + wc * 32 + 8 * fq;
#pragma unroll
        for (int ai = 0; ai < 2; ++ai)
#pragma unroll
            for (int m = 0; m < 4; ++m) { bf16_t* rowp = O + (size_t)(row0 + ai * HALF + m * 16) * ldc + col0;
#pragma unroll
                for (int bj = 0; bj < 2; ++bj) { const f32x4 v0 = acc[ai][bj][m][0], v1 = acc[ai][bj][m][1];
                    u32x4 w; w.x = cvt_pk_bf16(v0[0], v0[1]); w.y = cvt_pk_bf16(v0[2], v0[3]); w.z = cvt_pk_bf16(v1[0], v1[1]); w.w = cvt_pk_bf16(v1[2], v1[3]);
                    *(u32x4*)(rowp + bj * HALF) = w; } }
    }
};
struct EpiF32 {
    static constexpr bool PERM = false, AFTER_DRAIN = false;
    float* O; int ldc;
    __device__ __forceinline__ void operator()(const f32x4 (&acc)[2][2][4][2], const Unit& u, int wr, int wc, int fr, int fq) const {
        const int row0 = u.pm * BM + wr * 64 + fr; const int col0 = u.pn * BM + wc * 32 + 4 * fq;
#pragma unroll
        for (int ai = 0; ai < 2; ++ai)
#pragma unroll
            for (int m = 0; m < 4; ++m) { float* rowp = O + (size_t)(row0 + ai * HALF + m * 16) * ldc + col0;
#pragma unroll
                for (int bj = 0; bj < 2; ++bj)
#pragma unroll
                    for (int n = 0; n < 2; ++n) *(f32x4*)(rowp + bj * HALF + n * 16) = acc[ai][bj][m][n]; }
    }
};
template <class Epi, class Sched, bool ALIGN_EPI = false, bool SP2 = false>
__device__ __forceinline__ void gemm_phase(const int tid_in, PG8_LAS unsigned char* lds, const Gemm g, const Sched& S, const Epi& E) {
    const int tid = tid_in, wid = __builtin_amdgcn_readfirstlane(tid >> 6), lane = tid & 63, wr = wid >> 2, wc = wid & 3, fr = lane & 15, fq = lane >> 4;
    const int K = g.K, nt = K / BK;
    unsigned voffA[2], voffB[2];
#pragma unroll
    for (int i = 0; i < 2; ++i) { int R, C; stage_rc(tid * 16 + i * 8192, R, C); const int Rb = Epi::PERM ? ((R & ~31) + perm32(R & 31)) : R;
        voffA[i] = (unsigned)(R * K + C) * 2u; voffB[i] = (unsigned)(Rb * K + C) * 2u; }
    const size_t kstep = (size_t)(BK * 2);
    const size_t hstep = (size_t)HALF * K * 2;
    const size_t tstep = 2 * hstep;
    const unsigned ldsw = (unsigned)wid * 1024u;
    const int aoff = lds_byte(wr * 64 + fr, fq * 8), boff = lds_byte(wc * 32 + fr, fq * 8);
#define PG8_SA(b, h) (((b) * 2 + (h)) * HTB)
#define PG8_SB(b, h) ((4 + (b) * 2 + (h)) * HTB)
#define PG8_STAGE(bufoff, gbase, voff) do { _Pragma("unroll") for (int _i = 0; _i < 2; ++_i) \
        __builtin_amdgcn_global_load_lds((const unsigned*)((const char*)(gbase) + (voff)[_i]), (PG8_LAS unsigned*)(lds + (bufoff) + ldsw + _i * 8192), 16, 0, 0); } while (0)
#define PG8_LDA(dst, b, h) do { _Pragma("unroll") for (int m = 0; m < 4; ++m) _Pragma("unroll") for (int k = 0; k < 2; ++k) dst[m][k] = *(const PG8_LAS bf16x8*)(lds + PG8_SA(b, h) + aoff + m * 2048 + k * 1024); } while (0)
#define PG8_LDB(dst, b, h) do { _Pragma("unroll") for (int n = 0; n < 2; ++n) _Pragma("unroll") for (int k = 0; k < 2; ++k) dst[n][k] = *(const PG8_LAS bf16x8*)(lds + PG8_SB(b, h) + boff + n * 2048 + k * 1024); } while (0)
#define PG8_MMA(ai, bj, At, Bt) do { __builtin_amdgcn_s_setprio(1); _Pragma("unroll") for (int m = 0; m < 4; ++m) _Pragma("unroll") for (int n = 0; n < 2; ++n) _Pragma("unroll") for (int k = 0; k < 2; ++k) \
        acc[ai][bj][m][n] = __builtin_amdgcn_mfma_f32_16x16x32_bf16(Bt[n][k], At[m][k], acc[ai][bj][m][n], 0, 0, 0); __builtin_amdgcn_s_setprio(0); } while (0)
#define PG8_WAIT_V(n) asm volatile("s_waitcnt vmcnt(" #n ")" ::: "memory")
#define PG8_WAIT_L(n) asm volatile("s_waitcnt lgkmcnt(" #n ")" ::: "memory")
#define PG8_BAR __builtin_amdgcn_s_barrier()
#define PG8_SCHED __builtin_amdgcn_sched_barrier(0)
    Unit cur, nxt; int ui = 0;
    if (!S.next(0, cur)) return;
    f32x4 acc[2][2][4][2];
#pragma unroll
    for (int a = 0; a < 2; ++a)
#pragma unroll
        for (int b = 0; b < 2; ++b)
#pragma unroll
            for (int m = 0; m < 4; ++m)
#pragma unroll
                for (int n = 0; n < 2; ++n) acc[a][b][m][n] = (f32x4){0.f, 0.f, 0.f, 0.f};
    bf16x8 At[4][2], B0[2][2], B1[2][2];
    const char* cA = (const char*)g.A + (size_t)cur.pm * tstep; const char* cB = (const char*)g.Bt + (size_t)cur.pn * tstep;
    S.a_ready(cur);
    if constexpr (SP2) {
        PG8_STAGE(PG8_SB(0, 0), cB, voffB); PG8_STAGE(PG8_SB(0, 1), cB + hstep, voffB); PG8_STAGE(PG8_SA(0, 0), cA, voffA); PG8_STAGE(PG8_SA(0, 1), cA + hstep, voffA);
        if (wr == 1) PG8_BAR;
        PG8_WAIT_V(2); PG8_BAR;
        PG8_STAGE(PG8_SB(1, 0), cB + kstep, voffB); PG8_STAGE(PG8_SA(1, 0), cA + kstep, voffA); PG8_STAGE(PG8_SB(1, 1), cB + hstep + kstep, voffB);
        PG8_WAIT_V(6); PG8_BAR;
    } else {
        PG8_STAGE(PG8_SB(0, 0), cB, voffB); PG8_STAGE(PG8_SA(0, 0), cA, voffA); PG8_STAGE(PG8_SB(0, 1), cB + hstep, voffB); PG8_STAGE(PG8_SA(0, 1), cA + hstep, voffA);
        if (wr == 1) PG8_BAR;
        PG8_WAIT_V(4); PG8_BAR;
        PG8_STAGE(PG8_SB(1, 0), cB + kstep, voffB); PG8_STAGE(PG8_SA(1, 0), cA + kstep, voffA); PG8_STAGE(PG8_SB(1, 1), cB + hstep + kstep, voffB);
        PG8_WAIT_V(6); PG8_BAR;
    }
    for (;;) {
        const bool has_next = S.next(ui + 1, nxt);
        const char* nA = has_next ? (const char*)g.A + (size_t)nxt.pm * tstep : cA; const char* nB = has_next ? (const char*)g.Bt + (size_t)nxt.pn * tstep : cB;
        for (int t = 0; t < nt; t += 2) {
            const bool last = (t == nt - 2);
            const char* a1 = cA + (size_t)(t + 1) * kstep;
            const char* a2 = last ? nA : cA + (size_t)(t + 2) * kstep; const char* b2 = last ? nB : cB + (size_t)(t + 2) * kstep;
            const char* a3 = a2 + kstep; const char* b3 = b2 + kstep;
            if (last && has_next) S.a_ready(nxt);
            if constexpr (SP2) {
            PG8_LDB(B0, 0, 0); PG8_LDB(B1, 0, 1); PG8_SCHED; PG8_LDA(At, 0, 0); PG8_STAGE(PG8_SA(1, 1), a1 + hstep, voffA);
            PG8_WAIT_V(8); PG8_WAIT_L(0); PG8_BAR; PG8_MMA(0, 0, At, B0); PG8_MMA(0, 1, At, B1); PG8_BAR; PG8_SCHED;
            PG8_LDA(At, 0, 1); PG8_STAGE(PG8_SB(0, 0), b2, voffB); PG8_STAGE(PG8_SB(0, 1), b2 + hstep, voffB); PG8_STAGE(PG8_SA(0, 0), a2, voffA);
            PG8_WAIT_V(8); PG8_WAIT_L(0); PG8_BAR; PG8_MMA(1, 0, At, B0); PG8_MMA(1, 1, At, B1); PG8_BAR; PG8_SCHED;
            PG8_LDB(B0, 1, 0); PG8_LDB(B1, 1, 1); PG8_SCHED; PG8_LDA(At, 1, 0); PG8_STAGE(PG8_SA(0, 1), a2 + hstep, voffA);
            PG8_WAIT_V(8); PG8_WAIT_L(0); PG8_BAR; PG8_MMA(0, 0, At, B0); PG8_MMA(0, 1, At, B1); PG8_BAR; PG8_SCHED;
            PG8_LDA(At, 1, 1); PG8_STAGE(PG8_SB(1, 0), b3, voffB); PG8_STAGE(PG8_SB(1, 1), b3 + hstep, voffB); PG8_STAGE(PG8_SA(1, 0), a3, voffA);
            PG8_WAIT_V(8); PG8_WAIT_L(0); PG8_BAR; PG8_MMA(1, 0, At, B0); PG8_MMA(1, 1, At, B1); PG8_BAR; PG8_SCHED;
            } else {
            PG8_LDB(B0, 0, 0); PG8_SCHED; PG8_LDA(At, 0, 0); PG8_STAGE(PG8_SA(1, 1), a1 + hstep, voffA);
            PG8_WAIT_L(8); PG8_BAR; PG8_WAIT_L(0); PG8_MMA(0, 0, At, B0); PG8_BAR; PG8_SCHED;
            PG8_LDB(B1, 0, 1); PG8_STAGE(PG8_SB(0, 0), b2, voffB);
            PG8_BAR; PG8_WAIT_L(0); PG8_MMA(0, 1, At, B1); PG8_BAR;
            PG8_LDA(At, 0, 1); PG8_STAGE(PG8_SA(0, 0), a2, voffA);
            PG8_BAR; PG8_WAIT_L(0); PG8_MMA(1, 0, At, B0); PG8_BAR; PG8_SCHED;
            PG8_STAGE(PG8_SB(0, 1), b2 + hstep, voffB);
            PG8_WAIT_V(6); PG8_BAR; PG8_MMA(1, 1, At, B1); PG8_BAR;
            PG8_LDB(B0, 1, 0); PG8_SCHED; PG8_LDA(At, 1, 0); PG8_STAGE(PG8_SA(0, 1), a2 + hstep, voffA);
            PG8_WAIT_L(8); PG8_BAR; PG8_WAIT_L(0); PG8_MMA(0, 0, At, B0); PG8_BAR; PG8_SCHED;
            PG8_LDB(B1, 1, 1); PG8_STAGE(PG8_SB(1, 0), b3, voffB);
            PG8_BAR; PG8_WAIT_L(0); PG8_MMA(0, 1, At, B1); PG8_BAR;
            PG8_LDA(At, 1, 1); PG8_STAGE(PG8_SA(1, 0), a3, voffA);
            PG8_BAR; PG8_WAIT_L(0); PG8_MMA(1, 0, At, B0); PG8_BAR; PG8_SCHED;
            PG8_STAGE(PG8_SB(1, 1), b3 + hstep, voffB);
            PG8_WAIT_V(6); PG8_BAR; PG8_MMA(1, 1, At, B1); PG8_BAR;
            }
        }
        if constexpr (ALIGN_EPI) { if (wr == 0) PG8_BAR; }
        if constexpr (!Epi::AFTER_DRAIN) { E(acc, cur, wr, wc, fr, fq); S.done(cur); }
        if (!has_next) break;
#pragma unroll
        for (int a = 0; a < 2; ++a)
#pragma unroll
            for (int b = 0; b < 2; ++b)
#pragma unroll
                for (int m = 0; m < 4; ++m)
#pragma unroll
                    for (int n = 0; n < 2; ++n) acc[a][b][m][n] = (f32x4){0.f, 0.f, 0.f, 0.f};
        cur = nxt; cA = nA; cB = nB; ++ui;
        if constexpr (ALIGN_EPI) { if (wr == 1) PG8_BAR; }
    }
    PG8_WAIT_V(0);
    if constexpr (!ALIGN_EPI) { if (wr == 0) PG8_BAR; }
    PG8_BAR;
    if constexpr (Epi::AFTER_DRAIN) { E.fused(acc, cur, wr, wc, fr, fq, lds, wid, lane); S.done(cur); }
#undef PG8_SA
#undef PG8_SB
#undef PG8_STAGE
#undef PG8_LDA
#undef PG8_LDB
#undef PG8_MMA
#undef PG8_WAIT_V
#undef PG8_WAIT_L
#undef PG8_BAR
#undef PG8_SCHED
}
}

#define LAS __attribute__((address_space(3)))
#define DI __device__ __forceinline__
struct Ctx { int tid, bid, nb; };
typedef unsigned short bf16;
typedef short bf16x8 __attribute__((ext_vector_type(8)));
typedef float f32x4 __attribute__((ext_vector_type(4)));
typedef float f32x16 __attribute__((ext_vector_type(16)));
typedef unsigned u32x4 __attribute__((ext_vector_type(4)));
typedef unsigned u32x2 __attribute__((ext_vector_type(2)));

constexpr int BATCH = 2, SEQ = 8192, DM = 1024, M = BATCH * SEQ, DEPTH = 4;
constexpr int DIN = 3104, NP = 3072, DFF = 2816, NUP = 5632, NHEAD = 4;
constexpr int OFF_GB = 0, OFF_GC = 512, OFF_GV = 1024, OFF_Q = 1536, OFF_K = 1792, OFF_V = 2048, OFF_GO = 2560;
constexpr float EPS = 1e-6f;
constexpr int NCHUNK = SEQ / 64;
constexpr int PH_PER_LAYER = 10, N_PHASES = DEPTH * PH_PER_LAYER + 1;

constexpr size_t MiB = 1u << 20;
constexpr size_t WS_WIN = 1 * MiB, WS_WOUT = 7 * MiB, WS_WUP = 9 * MiB, WS_WDOWN = 20 * MiB, WS_WLR = 26 * MiB;
constexpr size_t WS_H = 27 * MiB, WS_GUT = 26 * MiB + 65536, WS_SP = 254 * MiB;
constexpr size_t WS_P = 59 * MiB, WS_KV = 155 * MiB, WS_YMIX = 219 * MiB, WS_LR = 251 * MiB, WS_DEC = 253 * MiB;
constexpr size_t WS_Y = 59 * MiB, WS_U = 59 * MiB, WS_G = 235 * MiB, WS_END = 323 * MiB;
constexpr int LDS_BYTES = 150 * 1024, XB_LDS_OFF = 153088;

DI float bf_lo(unsigned w) { return __uint_as_float(w << 16); }
DI float bf_hi(unsigned w) { return __uint_as_float(w & 0xffff0000u); }
DI unsigned f2bf(float f) { unsigned u = __float_as_uint(f); return (u + 0x7fffu + ((u >> 16) & 1u)) >> 16; }
typedef float f32x2_t __attribute__((ext_vector_type(2)));
typedef __bf16 bf16x2_t __attribute__((ext_vector_type(2)));
DI unsigned pk2(float lo, float hi) { f32x2_t f = {lo, hi}; bf16x2_t b = __builtin_convertvector(f, bf16x2_t); return __builtin_bit_cast(unsigned, b); }
DI void unpack8(const u32x4 w, float (&f)[8]) { f[0] = bf_lo(w.x); f[1] = bf_hi(w.x); f[2] = bf_lo(w.y); f[3] = bf_hi(w.y); f[4] = bf_lo(w.z); f[5] = bf_hi(w.z); f[6] = bf_lo(w.w); f[7] = bf_hi(w.w); }
DI u32x4 pack8(const float (&f)[8]) { u32x4 w; w.x = pk2(f[0], f[1]); w.y = pk2(f[2], f[3]); w.z = pk2(f[4], f[5]); w.w = pk2(f[6], f[7]); return w; }
DI float wave_sum(float v) {
#pragma unroll
    for (int o = 1; o < 64; o <<= 1) v += __shfl_xor(v, o);
    return v;
}
DI int crow(int reg, int hh) { return (reg & 3) + 8 * (reg >> 2) + 4 * hh; }
#define MFMA32(a, b, c) __builtin_amdgcn_mfma_f32_32x32x16_bf16((a), (b), (c), 0, 0, 0)
#define LDS_WAIT() asm volatile("s_waitcnt lgkmcnt(0)" ::: "memory")

DI void transpose_item(const float* W, int ldw, int col0, int K, bf16* WT, LAS float* scr, int item, int nblk, int lane) {
    const int kb = item / nblk, nb = item % nblk, k0 = 64 * kb, n0 = 32 * nb;
#pragma unroll 8
    for (int i = 0; i < 32; ++i) { const int kk = 2 * i + (lane >> 5); scr[kk * 33 + (lane & 31)] = W[(size_t)(k0 + kk) * ldw + col0 + n0 + (lane & 31)]; }
    LDS_WAIT(); asm volatile("" ::: "memory");
    const int c = lane & 7;
#pragma unroll
    for (int j = 0; j < 4; ++j) { const int n = (lane >> 3) + 8 * j; const LAS float* s = scr + (8 * c) * 33 + n;
        u32x4 o; o.x = pk2(s[0 * 33], s[1 * 33]); o.y = pk2(s[2 * 33], s[3 * 33]); o.z = pk2(s[4 * 33], s[5 * 33]); o.w = pk2(s[6 * 33], s[7 * 33]);
        *(u32x4*)(WT + (size_t)(n0 + n) * K + k0 + 8 * c) = o; }
    LDS_WAIT(); asm volatile("" ::: "memory");
}
DI void convert_phase(const Ctx cx, const float* w_in, const float* w_out, const float* w_up, const float* w_down, const float* guf, const float* gub, unsigned char* ws, LAS unsigned char* lds) {
    { const int gt = cx.bid * 512 + cx.tid; if (gt < 8192) { const int dir = gt >> 12, ch = (gt >> 4) & 255, rr = gt & 15; ((bf16*)(ws + WS_GUT))[gt] = (bf16)f2bf((dir ? gub : guf)[rr * 256 + ch]); } }
    const int lane = cx.tid & 63, wave = cx.tid >> 6;
    LAS float* scr = (LAS float*)(lds + wave * 16384);
    const int gw = cx.bid * 8 + wave, NGW = cx.nb * 8;
    constexpr int I_IN = 16 * 96, I_LR = 16, I_OUT = 16 * 32, I_UP = 16 * 176, I_DOWN = 44 * 32;
    constexpr int NIT = I_IN + I_LR + I_OUT + I_UP + I_DOWN;
    for (int it = gw; it < NIT; it += NGW) {
        int r = it;
        if (r < I_IN) { transpose_item(w_in, DIN, 0, DM, (bf16*)(ws + WS_WIN), scr, r, 96, lane); continue; } r -= I_IN;
        if (r < I_LR) { transpose_item(w_in, DIN, NP, DM, (bf16*)(ws + WS_WLR), scr, r, 1, lane); continue; } r -= I_LR;
        if (r < I_OUT) { transpose_item(w_out, DM, 0, DM, (bf16*)(ws + WS_WOUT), scr, r, 32, lane); continue; } r -= I_OUT;
        if (r < I_UP) { transpose_item(w_up, NUP, 0, DM, (bf16*)(ws + WS_WUP), scr, r, 176, lane); continue; } r -= I_UP;
        transpose_item(w_down, DM, 0, DFF, (bf16*)(ws + WS_WDOWN), scr, r, 32, lane);
    }
}

DI void rows_phase(const Ctx cx, const float* xin, const float* y, const float* gpost, const float* gpre, float* xout, bf16* hout) {
    const int lane = cx.tid & 63, wave = cx.tid >> 6;
    const int gw = cx.bid * 8 + wave, NGW = cx.nb * 8;
    for (int mb = gw; mb < M / 2; mb += NGW) {
        f32x4 v[2][4], w[2][4];
#pragma unroll
        for (int q = 0; q < 2; ++q) { const int m = 2 * mb + q; const f32x4* xr = (const f32x4*)(xin + (size_t)m * DM) + lane;
#pragma unroll
            for (int j = 0; j < 4; ++j) v[q][j] = xr[64 * j];
            if (y) { const f32x4* yr = (const f32x4*)(y + (size_t)m * DM) + lane;
#pragma unroll
                for (int j = 0; j < 4; ++j) w[q][j] = yr[64 * j]; } }
#pragma unroll
        for (int q = 0; q < 2; ++q) { const int m = 2 * mb + q;
            if (y) { float ss = 0.f;
#pragma unroll
                for (int j = 0; j < 4; ++j) ss += (w[q][j].x * w[q][j].x + w[q][j].y * w[q][j].y) + (w[q][j].z * w[q][j].z + w[q][j].w * w[q][j].w);
                const float r = 1.0f / sqrtf(wave_sum(ss) * (1.0f / DM) + EPS);
#pragma unroll
                for (int j = 0; j < 4; ++j) { const f32x4 g = ((const f32x4*)gpost)[lane + 64 * j]; v[q][j] = v[q][j] + w[q][j] * r * g; } }
            if (xout) { f32x4* xo = (f32x4*)(xout + (size_t)m * DM) + lane;
#pragma unroll
                for (int j = 0; j < 4; ++j) xo[64 * j] = v[q][j]; }
            if (hout) { float ss = 0.f;
#pragma unroll
                for (int j = 0; j < 4; ++j) ss += (v[q][j].x * v[q][j].x + v[q][j].y * v[q][j].y) + (v[q][j].z * v[q][j].z + v[q][j].w * v[q][j].w);
                const float r = 1.0f / sqrtf(wave_sum(ss) * (1.0f / DM) + EPS);
                u32x2* ho = (u32x2*)(hout + (size_t)m * DM) + lane;
#pragma unroll
                for (int j = 0; j < 4; ++j) { const f32x4 g = ((const f32x4*)gpre)[lane + 64 * j]; const f32x4 o = v[q][j] * r * g;
                    u32x2 ww; ww.x = pk2(o.x, o.y); ww.y = pk2(o.z, o.w); ho[64 * j] = ww; } } }
    }
}

DI void lr_phase(const Ctx cx, const bf16* H, const bf16* WlrT, bf16* LRB, LAS unsigned char* lds) {
    const int tid = cx.tid, lane = tid & 63, wave = tid >> 6, r = lane & 31, hh = lane >> 5;
    LAS float* red = (LAS float*)lds;
    for (int ck = cx.bid; ck < M / 64; ck += cx.nb) {
        f32x16 acc0, acc1;
#pragma unroll
        for (int i = 0; i < 16; ++i) { acc0[i] = 0.f; acc1[i] = 0.f; }
#pragma unroll
        for (int s = 0; s < 8; ++s) { const int k0 = 128 * wave + 16 * s + 8 * hh;
            const bf16x8 b = *(const bf16x8*)(WlrT + (size_t)r * DM + k0);
            const bf16x8 a0 = *(const bf16x8*)(H + (size_t)(64 * ck + r) * DM + k0);
            const bf16x8 a1 = *(const bf16x8*)(H + (size_t)(64 * ck + 32 + r) * DM + k0);
            acc0 = MFMA32(a0, b, acc0); acc1 = MFMA32(a1, b, acc1); }
#pragma unroll
        for (int i = 0; i < 16; ++i) { red[(wave * 64 + crow(i, hh)) * 32 + r] = acc0[i]; red[(wave * 64 + 32 + crow(i, hh)) * 32 + r] = acc1[i]; }
        __syncthreads();
        for (int o = tid; o < 2048; o += 512) { float s = 0.f;
#pragma unroll
            for (int w = 0; w < 8; ++w) s += red[w * 2048 + o];
            LRB[(size_t)(64 * ck) * 32 + o] = (bf16)(pk2(s, s) & 0xffffu); }
        __syncthreads();
    }
}

DI void load_t(const bf16* P, int m, int c, float (&t)[8]) {
    const u32x4 a = *(const u32x4*)(P + (size_t)m * NP + OFF_GC + c), b = *(const u32x4*)(P + (size_t)m * NP + OFF_GV + c);
    float fa[8], fb[8]; unpack8(a, fa); unpack8(b, fb);
#pragma unroll
    for (int j = 0; j < 8; ++j) t[j] = fa[j] * fb[j];
}
DI void conva_phase(const Ctx cx, const bf16* P, const float* cw, bf16* YMIX) {
    const int gt = cx.bid * 512 + cx.tid, NT = cx.nb * 512;
    for (int it = gt; it < (M / 4) * 64; it += NT) {
        const int c = 8 * (it & 63), m0 = 4 * (it >> 6);
        u32x4 gc[6], gv[6], gb[4];
        const bool hasp = (m0 % SEQ) != 0, hasn = ((m0 + 4) % SEQ) != 0;
#pragma unroll
        for (int r = 0; r < 6; ++r) { const int m = m0 - 1 + r; const bool ok = (r == 0) ? hasp : (r == 5 ? hasn : true);
            if (ok) { gc[r] = *(const u32x4*)(P + (size_t)m * NP + OFF_GC + c); gv[r] = *(const u32x4*)(P + (size_t)m * NP + OFF_GV + c); }
            else { gc[r] = (u32x4){0u, 0u, 0u, 0u}; gv[r] = (u32x4){0u, 0u, 0u, 0u}; } }
#pragma unroll
        for (int r = 0; r < 4; ++r) gb[r] = *(const u32x4*)(P + (size_t)(m0 + r) * NP + OFF_GB + c);
        float w0[8], w1[8], w2[8];
#pragma unroll
        for (int j = 0; j < 8; ++j) { w0[j] = cw[c + j]; w1[j] = cw[512 + c + j]; w2[j] = cw[1024 + c + j]; }
        float tt[6][8];
#pragma unroll
        for (int r = 0; r < 6; ++r) { float fa[8], fb[8]; unpack8(gc[r], fa); unpack8(gv[r], fb);
#pragma unroll
            for (int j = 0; j < 8; ++j) tt[r][j] = fa[j] * fb[j]; }
#pragma unroll
        for (int r = 0; r < 4; ++r) { float g8[8], o[8]; unpack8(gb[r], g8);
#pragma unroll
            for (int j = 0; j < 8; ++j) o[j] = g8[j] * (w0[j] * tt[r][j] + w1[j] * tt[r + 1][j] + w2[j] * tt[r + 2][j]);
            *(u32x4*)(YMIX + (size_t)(m0 + r) * DM + c) = pack8(o); }
    }
}

DI float logsig16(float x) { return (fminf(x, 0.f) - __logf(1.0f + __expf(-fabsf(x)))) * (1.0f / 16.0f); }
DI void gla_gates_mfma(int wave, int lane, const bf16* LRB, const bf16* GUT, const float* bias_f, const float* bias_b, int m0, int h, LAS float* cumF, LAS float* cumB) {
    const int r = lane & 31, hh = lane >> 5, dir = wave >> 1, ct = wave & 1, ch = 64 * h + 32 * ct + r;
    const bf16x8 b = *(const bf16x8*)(GUT + ((size_t)(dir * 256 + ch) * 16 + 8 * hh));
    const bf16x8 a0 = *(const bf16x8*)(LRB + (size_t)(m0 + r) * 32 + 16 * dir + 8 * hh);
    const bf16x8 a1 = *(const bf16x8*)(LRB + (size_t)(m0 + 32 + r) * 32 + 16 * dir + 8 * hh);
    const float bias = (dir ? bias_b : bias_f)[ch];
    f32x16 z;
#pragma unroll
    for (int i = 0; i < 16; ++i) z[i] = 0.f;
    f32x16 acc[2]; acc[0] = MFMA32(a0, b, z); acc[1] = MFMA32(a1, b, z);
    LAS float* cum = (dir ? cumB : cumF) + 32 * ct + r;
    float base = 0.f;
    if (dir == 0) {
#pragma unroll
        for (int mt = 0; mt < 2; ++mt)
#pragma unroll
            for (int q = 0; q < 4; ++q) {
                const float p0 = logsig16(acc[mt][4 * q] + bias), p1 = p0 + logsig16(acc[mt][4 * q + 1] + bias), p2 = p1 + logsig16(acc[mt][4 * q + 2] + bias), p3 = p2 + logsig16(acc[mt][4 * q + 3] + bias);
                const float other = __shfl_xor(p3, 32), off = base + (hh ? other : 0.f); const int t0 = 32 * mt + 8 * q + 4 * hh;
                cum[(t0 + 0) * 64] = off + p0; cum[(t0 + 1) * 64] = off + p1; cum[(t0 + 2) * 64] = off + p2; cum[(t0 + 3) * 64] = off + p3;
                base += p3 + other; }
    } else {
#pragma unroll
        for (int mt = 1; mt >= 0; --mt)
#pragma unroll
            for (int q = 3; q >= 0; --q) {
                const float s3 = logsig16(acc[mt][4 * q + 3] + bias), s2 = s3 + logsig16(acc[mt][4 * q + 2] + bias), s1 = s2 + logsig16(acc[mt][4 * q + 1] + bias), s0 = s1 + logsig16(acc[mt][4 * q] + bias);
                const float other = __shfl_xor(s0, 32), off = base + (hh ? 0.f : other); const int t0 = 32 * mt + 8 * q + 4 * hh;
                cum[(t0 + 0) * 64] = off + s0; cum[(t0 + 1) * 64] = off + s1; cum[(t0 + 2) * 64] = off + s2; cum[(t0 + 3) * 64] = off + s3;
                base += s0 + other; }
    }
}
constexpr int LS = 72;
constexpr int OS = 136;
struct GlaP { const bf16* P; const bf16* LRB; const bf16* GUT; const float *gbf, *gbb, *hn; float* KV; float* DEC; bf16* SP; bf16* YMIX; };
DI void write_vT(LAS bf16* vT, const u32x4 vv, int t, int c8) {
    const unsigned w[4] = {vv.x, vv.y, vv.z, vv.w};
#pragma unroll
    for (int j = 0; j < 4; ++j) { vT[(8 * c8 + 2 * j) * LS + t] = (bf16)(w[j] & 0xffffu); vT[(8 * c8 + 2 * j + 1) * LS + t] = (bf16)(w[j] >> 16); }
}

DI void gla_pass1(const Ctx cx, const GlaP& g, LAS unsigned char* lds) {
    const int tid = cx.tid, lane = tid & 63, wave = tid >> 6, r = lane & 31, hh = lane >> 5;
    LAS float* cumF = (LAS float*)lds; LAS float* cumB = (LAS float*)(lds + 16384);
    LAS bf16* kTf = (LAS bf16*)(lds + 32768); LAS bf16* kTb = kTf + 64 * LS; LAS bf16* vT = kTb + 64 * LS;
    for (int u = cx.bid; u < BATCH * NHEAD * NCHUNK; u += cx.nb) {
        const int bh = u >> 7, c = u & 127, b = bh >> 2, h = bh & 3, m0 = b * SEQ + 64 * c;
        const int t = tid >> 3, c8 = tid & 7;
        const u32x4 kraw = *(const u32x4*)(g.P + (size_t)(m0 + t) * NP + OFF_K + 64 * h + 8 * c8);
        const u32x4 v0 = *(const u32x4*)(g.P + (size_t)(m0 + (tid >> 4)) * NP + OFF_V + 128 * h + 8 * (tid & 15));
        const u32x4 v1 = *(const u32x4*)(g.P + (size_t)(m0 + 32 + (tid >> 4)) * NP + OFF_V + 128 * h + 8 * (tid & 15));
        if (wave < 4) gla_gates_mfma(wave, lane, g.LRB, g.GUT, g.gbf, g.gbb, m0, h, cumF, cumB);
        write_vT(vT, v0, tid >> 4, tid & 15); write_vT(vT, v1, 32 + (tid >> 4), tid & 15);
        __syncthreads();
        { float kk[8]; unpack8(kraw, kk);
#pragma unroll
          for (int j = 0; j < 8; j += 2) { const int d = 8 * c8 + j;
              const unsigned pf = pk2(kk[j] * __expf(cumF[63 * 64 + d] - cumF[t * 64 + d]), kk[j + 1] * __expf(cumF[63 * 64 + d + 1] - cumF[t * 64 + d + 1]));
              const unsigned pb = pk2(kk[j] * __expf(cumB[d] - cumB[t * 64 + d]), kk[j + 1] * __expf(cumB[d + 1] - cumB[t * 64 + d + 1]));
              kTf[d * LS + t] = (bf16)(pf & 0xffffu); kTf[(d + 1) * LS + t] = (bf16)(pf >> 16);
              kTb[d * LS + t] = (bf16)(pb & 0xffffu); kTb[(d + 1) * LS + t] = (bf16)(pb >> 16); } }
        __syncthreads();
        { const int dir = wave >> 2, dvt = wave & 3; const LAS bf16* kT = dir ? kTb : kTf;
          f32x16 acc[2];
#pragma unroll
          for (int i = 0; i < 16; ++i) { acc[0][i] = 0.f; acc[1][i] = 0.f; }
#pragma unroll
          for (int ks = 0; ks < 4; ++ks) { const bf16x8 a = *(const LAS bf16x8*)(vT + (32 * dvt + r) * LS + 16 * ks + 8 * hh);
#pragma unroll
              for (int dkt = 0; dkt < 2; ++dkt) { const bf16x8 bb = *(const LAS bf16x8*)(kT + (32 * dkt + r) * LS + 16 * ks + 8 * hh); acc[dkt] = MFMA32(a, bb, acc[dkt]); } }
          float* KVp = g.KV + ((size_t)((bh * 2 + dir) * NCHUNK + c)) * 8192;
#pragma unroll
          for (int dkt = 0; dkt < 2; ++dkt)
#pragma unroll
              for (int i = 0; i < 16; ++i) KVp[(32 * dvt + crow(i, hh)) * 64 + 32 * dkt + r] = acc[dkt][i]; }
        if (tid < 128) { const int dir = tid >> 6, d = tid & 63; g.DEC[((size_t)((bh * 2 + dir) * NCHUNK + c)) * 64 + d] = __expf(dir ? cumB[d] : cumF[63 * 64 + d]); }
        __syncthreads();
    }
}
DI void gla_scan(const Ctx cx, const float* KV, const float* DEC, bf16* SP) {
    const int gt = cx.bid * 512 + cx.tid, NT = cx.nb * 512;
    for (int e = gt; e < 16 * 8192; e += NT) {
        const int bhd = e >> 13, el = e & 8191, dk = el & 63, dir = bhd & 1;
        const float* kv = KV + (size_t)bhd * NCHUNK * 8192 + el; const float* dc = DEC + (size_t)bhd * NCHUNK * 64 + dk; bf16* sp = SP + (size_t)bhd * NCHUNK * 8192 + el;
        float s = 0.f;
        for (int n0 = 0; n0 < NCHUNK; n0 += 16) {
            float x[16], d[16];
#pragma unroll
            for (int i = 0; i < 16; ++i) { const int n = dir ? (NCHUNK - 1 - n0 - i) : (n0 + i); x[i] = kv[(size_t)n * 8192]; d[i] = dc[n * 64]; }
#pragma unroll
            for (int i = 0; i < 16; ++i) { const int n = dir ? (NCHUNK - 1 - n0 - i) : (n0 + i); sp[(size_t)n * 8192] = (bf16)(pk2(s, s) & 0xffffu); s = d[i] * s + x[i]; }
        }
    }
}
DI void gla_pass3(const Ctx cx, const GlaP& g, LAS unsigned char* lds) {
    const int tid = cx.tid, lane = tid & 63, wave = tid >> 6, r = lane & 31, hh = lane >> 5;
    LAS float* cumF = (LAS float*)lds; LAS float* cumB = (LAS float*)(lds + 16384);
    LAS bf16* qf = (LAS bf16*)(lds + 32768); LAS bf16* kf = qf + 64 * LS; LAS bf16* qb = kf + 64 * LS; LAS bf16* kb = qb + 64 * LS;
    LAS bf16* vT = kb + 64 * LS; LAS bf16* SfT = vT + 128 * LS; LAS bf16* SbT = SfT + 128 * LS; LAS bf16* Sc = SbT + 128 * LS;
    LAS float* part = (LAS float*)(Sc + 64 * LS);
    LAS bf16* Ost = (LAS bf16*)(part + 256);
    const int t = tid >> 3, c8 = tid & 7;
    float gn[16];
#pragma unroll
    for (int j = 0; j < 16; ++j) gn[j] = g.hn[16 * c8 + j];
    for (int u = cx.bid; u < BATCH * NHEAD * NCHUNK; u += cx.nb) {
        const int bh = u >> 7, c = u & 127, b = bh >> 2, h = bh & 3, m0 = b * SEQ + 64 * c;
        const u32x4 qraw = *(const u32x4*)(g.P + (size_t)(m0 + t) * NP + OFF_Q + 64 * h + 8 * c8);
        const u32x4 kraw = *(const u32x4*)(g.P + (size_t)(m0 + t) * NP + OFF_K + 64 * h + 8 * c8);
        const u32x4 v0 = *(const u32x4*)(g.P + (size_t)(m0 + (tid >> 4)) * NP + OFF_V + 128 * h + 8 * (tid & 15));
        const u32x4 v1 = *(const u32x4*)(g.P + (size_t)(m0 + 32 + (tid >> 4)) * NP + OFF_V + 128 * h + 8 * (tid & 15));
        const bf16* SPf = g.SP + ((size_t)((bh * 2 + 0) * NCHUNK + c)) * 8192; const bf16* SPb = g.SP + ((size_t)((bh * 2 + 1) * NCHUNK + c)) * 8192;
        const u32x4 sf0 = *(const u32x4*)(SPf + 8 * tid), sf1 = *(const u32x4*)(SPf + 8 * (tid + 512));
        const u32x4 sb0 = *(const u32x4*)(SPb + 8 * tid), sb1 = *(const u32x4*)(SPb + 8 * (tid + 512));
        const u32x4 go0 = *(const u32x4*)(g.P + (size_t)(m0 + t) * NP + OFF_GO + 128 * h + 16 * c8), go1 = *(const u32x4*)(g.P + (size_t)(m0 + t) * NP + OFF_GO + 128 * h + 16 * c8 + 8);
        if (wave < 4) gla_gates_mfma(wave, lane, g.LRB, g.GUT, g.gbf, g.gbb, m0, h, cumF, cumB);
        write_vT(vT, v0, tid >> 4, tid & 15); write_vT(vT, v1, 32 + (tid >> 4), tid & 15);
        *(LAS u32x4*)(SfT + (tid >> 3) * LS + 8 * (tid & 7)) = sf0; *(LAS u32x4*)(SfT + (64 + (tid >> 3)) * LS + 8 * (tid & 7)) = sf1;
        *(LAS u32x4*)(SbT + (tid >> 3) * LS + 8 * (tid & 7)) = sb0; *(LAS u32x4*)(SbT + (64 + (tid >> 3)) * LS + 8 * (tid & 7)) = sb1;
        __syncthreads();
        { float qq[8], kk[8]; unpack8(qraw, qq); unpack8(kraw, kk);
          float o1[8], o2[8], o3[8], o4[8];
#pragma unroll
          for (int j = 0; j < 8; ++j) { const int d = 8 * c8 + j; const float cf = cumF[t * 64 + d], cb = cumB[t * 64 + d];
              o1[j] = qq[j] * 0.125f * __expf(cf); o2[j] = kk[j] * __expf(-cf); o3[j] = qq[j] * 0.125f * __expf(cb); o4[j] = kk[j] * __expf(-cb); }
          *(LAS u32x4*)(qf + t * LS + 8 * c8) = pack8(o1); *(LAS u32x4*)(kf + t * LS + 8 * c8) = pack8(o2);
          *(LAS u32x4*)(qb + t * LS + 8 * c8) = pack8(o3); *(LAS u32x4*)(kb + t * LS + 8 * c8) = pack8(o4); }
        __syncthreads();
        if (wave < 4) { const int ti = wave >> 1, tj = wave & 1;
            f32x16 tot;
#pragma unroll
            for (int i = 0; i < 16; ++i) tot[i] = 0.f;
            if (ti >= tj) { f32x16 acc;
#pragma unroll
                for (int i = 0; i < 16; ++i) acc[i] = 0.f;
#pragma unroll
                for (int ks = 0; ks < 4; ++ks) acc = MFMA32(*(const LAS bf16x8*)(qf + (32 * ti + r) * LS + 16 * ks + 8 * hh), *(const LAS bf16x8*)(kf + (32 * tj + r) * LS + 16 * ks + 8 * hh), acc);
#pragma unroll
                for (int i = 0; i < 16; ++i) { const int ii = 32 * ti + crow(i, hh), jj = 32 * tj + r; tot[i] += (jj <= ii) ? acc[i] : 0.f; } }
            if (ti <= tj) { f32x16 acc;
#pragma unroll
                for (int i = 0; i < 16; ++i) acc[i] = 0.f;
#pragma unroll
                for (int ks = 0; ks < 4; ++ks) acc = MFMA32(*(const LAS bf16x8*)(qb + (32 * ti + r) * LS + 16 * ks + 8 * hh), *(const LAS bf16x8*)(kb + (32 * tj + r) * LS + 16 * ks + 8 * hh), acc);
#pragma unroll
                for (int i = 0; i < 16; ++i) { const int ii = 32 * ti + crow(i, hh), jj = 32 * tj + r; tot[i] += (jj >= ii) ? acc[i] : 0.f; } }
#pragma unroll
            for (int i = 0; i < 16; ++i) Sc[(32 * ti + crow(i, hh)) * LS + 32 * tj + r] = (bf16)(pk2(tot[i], tot[i]) & 0xffffu);
        }
        __syncthreads();
        { const int ti = wave >> 2, tj = wave & 3;
          f32x16 acc;
#pragma unroll
          for (int i = 0; i < 16; ++i) acc[i] = 0.f;
#pragma unroll
          for (int ks = 0; ks < 4; ++ks) acc = MFMA32(*(const LAS bf16x8*)(Sc + (32 * ti + r) * LS + 16 * ks + 8 * hh), *(const LAS bf16x8*)(vT + (32 * tj + r) * LS + 16 * ks + 8 * hh), acc);
#pragma unroll
          for (int ks = 0; ks < 4; ++ks) acc = MFMA32(*(const LAS bf16x8*)(qf + (32 * ti + r) * LS + 16 * ks + 8 * hh), *(const LAS bf16x8*)(SfT + (32 * tj + r) * LS + 16 * ks + 8 * hh), acc);
#pragma unroll
          for (int ks = 0; ks < 4; ++ks) acc = MFMA32(*(const LAS bf16x8*)(qb + (32 * ti + r) * LS + 16 * ks + 8 * hh), *(const LAS bf16x8*)(SbT + (32 * tj + r) * LS + 16 * ks + 8 * hh), acc);
#pragma unroll
          for (int i = 0; i < 16; ++i) Ost[(32 * ti + crow(i, hh)) * OS + 32 * tj + r] = (bf16)(pk2(acc[i], acc[i]) & 0xffffu); }
        __syncthreads();
        { float o[16], gg[16]; unpack8(*(const LAS u32x4*)(Ost + t * OS + 16 * c8), *(float(*)[8])&o[0]); unpack8(*(const LAS u32x4*)(Ost + t * OS + 16 * c8 + 8), *(float(*)[8])&o[8]);
          float ss = 0.f;
#pragma unroll
          for (int j = 0; j < 16; ++j) ss += o[j] * o[j];
          ss += __shfl_xor(ss, 1); ss += __shfl_xor(ss, 2); ss += __shfl_xor(ss, 4);
          const float rs = 1.0f / sqrtf(ss * (1.0f / 128.0f) + EPS);
          unpack8(go0, *(float(*)[8])&gg[0]); unpack8(go1, *(float(*)[8])&gg[8]);
          float y[16];
#pragma unroll
          for (int j = 0; j < 16; ++j) y[j] = gg[j] / (1.0f + __expf(-gg[j])) * (o[j] * rs * gn[j]);
          bf16* yp = g.YMIX + (size_t)(m0 + t) * DM + 512 + 128 * h + 16 * c8;
          *(u32x4*)yp = pack8(*(const float(*)[8])&y[0]); *(u32x4*)(yp + 8) = pack8(*(const float(*)[8])&y[8]); }
    }
}

DI void ffn_conv_phase(const Ctx cx, const bf16* U, const float* cw, bf16* G) {
    const int gt = cx.bid * 512 + cx.tid, NT = cx.nb * 512;
    constexpr int NG = DFF / 8, RB = 8;
    for (int it = gt; it < (M / RB) * NG; it += NT) {
        const int c = 8 * (it % NG), m0 = RB * (it / NG);
        u32x4 ug[RB + 2], uv[RB + 2];
        const bool hasp = (m0 % SEQ) != 0, hasn = ((m0 + RB) % SEQ) != 0;
#pragma unroll
        for (int r = 0; r < RB + 2; ++r) { const int m = m0 - 1 + r; const bool ok = (r == 0) ? hasp : (r == RB + 1 ? hasn : true);
            if (ok) { ug[r] = *(const u32x4*)(U + (size_t)m * NUP + c); uv[r] = *(const u32x4*)(U + (size_t)m * NUP + DFF + c); }
            else { ug[r] = (u32x4){0u, 0u, 0u, 0u}; uv[r] = (u32x4){0u, 0u, 0u, 0u}; } }
        float wg[3][8], wv[3][8];
#pragma unroll
        for (int k = 0; k < 3; ++k)
#pragma unroll
            for (int j = 0; j < 8; ++j) { wg[k][j] = cw[k * NUP + c + j]; wv[k][j] = cw[k * NUP + DFF + c + j]; }
        float gp[8], gc[8], gn[8], vp[8], vc[8], vn[8];
        unpack8(ug[0], gp); unpack8(uv[0], vp); unpack8(ug[1], gc); unpack8(uv[1], vc);
#pragma unroll
        for (int r = 0; r < RB; ++r) { unpack8(ug[r + 2], gn); unpack8(uv[r + 2], vn);
            float o[8];
#pragma unroll
            for (int j = 0; j < 8; ++j) { const float a = wg[0][j] * gp[j] + wg[1][j] * gc[j] + wg[2][j] * gn[j], bq = wv[0][j] * vp[j] + wv[1][j] * vc[j] + wv[2][j] * vn[j];
                o[j] = a / (1.0f + __expf(-a)) * bq; gp[j] = gc[j]; gc[j] = gn[j]; vp[j] = vc[j]; vc[j] = vn[j]; }
            *(u32x4*)(G + (size_t)(m0 + r) * DFF + c) = pack8(o); }
    }
}

#define XB_TMO      128
#define XB_XCNT(j)  (256  + 64 * (j))
#define XB_XSUB(j)  (1280 + 64 * (j))
#define XB_XGEN(j)  (2304 + 64 * (j))
#define XB_TOP      3328
#define XB_TOPGEN   3392
#define XCD_BAR_WORDS 3456
#define XB_SPIN_CAP (1u << 18)

__device__ __forceinline__ unsigned xb_ld(unsigned* p)              { return __hip_atomic_load(p, __ATOMIC_RELAXED, __HIP_MEMORY_SCOPE_AGENT); }
__device__ __forceinline__ unsigned xb_add(unsigned* p, unsigned v) { return __hip_atomic_fetch_add(p, v, __ATOMIC_RELAXED, __HIP_MEMORY_SCOPE_AGENT); }
__device__ __forceinline__ unsigned xb_xcc_id() { return (unsigned)__builtin_amdgcn_s_getreg((3 << 11) | 20) & 0xFu; }
#define XB_SPIN(cond, bar) do { unsigned _sp = 0; while (cond) { __builtin_amdgcn_s_sleep(1); \
    if ((++_sp & 255u) == 0u) { if (xb_ld(&(bar)[XB_TMO])) break; if (_sp > XB_SPIN_CAP) { atomicAdd(&(bar)[XB_TMO], 1u); break; } } } } while (0)

struct XcdBarrier {
    unsigned* bar; unsigned x;
    volatile LAS unsigned* st;
};

__device__ __forceinline__ XcdBarrier xcd_barrier_post(unsigned* bar, volatile LAS unsigned* st) {
    XcdBarrier b; b.bar = bar; b.x = xb_xcc_id(); b.st = st;
    if (threadIdx.x == 0) (void)xb_add(&bar[XB_XCNT(b.x)], 1u);
    return b;
}
__device__ __forceinline__ void xcd_barrier_complete(unsigned* bar, unsigned x, unsigned& nloc, unsigned& nx) {
    const unsigned G = gridDim.x * gridDim.y * gridDim.z;
    unsigned sum, cnt, mine, sp = 0u;
    for (;;) {
        sum = 0u; cnt = 0u; mine = 0u;
#pragma unroll
        for (unsigned j = 0; j < 16; ++j) { const unsigned c = xb_ld(&bar[XB_XCNT(j)]); sum += c; cnt += (c > 0u) ? 1u : 0u; mine = (j == x) ? c : mine; }
        if (sum == G) break;
        __builtin_amdgcn_s_sleep(1);
        if ((++sp & 255u) == 0u) { if (xb_ld(&bar[XB_TMO])) break; if (sp > XB_SPIN_CAP) { atomicAdd(&bar[XB_TMO], 1u); break; } }
    }
    nloc = mine > 0u ? mine : 1u; nx = cnt > 0u ? cnt : 1u;
}

__device__ __forceinline__ void xcd_barrier(const XcdBarrier& b) {
    asm volatile("s_waitcnt vmcnt(0)" ::: "memory");
    __syncthreads();
    if (threadIdx.x == 0) {
        unsigned* bar = b.bar;
        __builtin_amdgcn_s_waitcnt(0);
        unsigned nloc = b.st[0], nx = b.st[1];
        if (nloc == 0u) { xcd_barrier_complete(bar, b.x, nloc, nx); b.st[0] = nloc; b.st[1] = nx; }
        const unsigned old = xb_add(&bar[XB_XSUB(b.x)], 1u);
        const unsigned gen = old / nloc;
        if (old + 1u == (gen + 1u) * nloc) {
            __builtin_amdgcn_fence(__ATOMIC_RELEASE, "agent");
            asm volatile("s_waitcnt vmcnt(0)" ::: "memory");
            const unsigned og = xb_add(&bar[XB_TOP], 1u);
            const unsigned tg = og / nx;
            if (og + 1u == (tg + 1u) * nx) xb_add(&bar[XB_TOPGEN], 1u);
            else XB_SPIN(xb_ld(&bar[XB_TOPGEN]) == tg, bar);
            __builtin_amdgcn_fence(__ATOMIC_ACQUIRE, "agent");
            xb_add(&bar[XB_XGEN(b.x)], 1u);
            asm volatile("s_waitcnt vmcnt(0)" ::: "memory");
        } else {
            XB_SPIN(xb_ld(&bar[XB_XGEN(b.x)]) == gen, bar);
            __builtin_amdgcn_fence(__ATOMIC_ACQUIRE, "agent");
            asm volatile("s_waitcnt vmcnt(0)" ::: "memory");
        }
    }
    __syncthreads();
}

#ifndef REPEAT_MASK
#define REPEAT_MASK 0
#endif
#ifndef PHASE_MASK
#define PHASE_MASK 0xffff
#endif
struct Args { const float* in[16]; float* out; unsigned char* ws; int ph_lo, ph_hi; };

template <class Epi> DI void run_gemm(const Ctx cx, LAS unsigned char* lds, const bf16* A, const bf16* Bt, int N, int K, const Epi& E) {
    pg8::Gemm g{A, Bt, M, N, K}; pg8::StaticOrder S; S.init(M, N, (int)cx.nb, (int)cx.bid);
    pg8::gemm_phase<Epi, pg8::StaticOrder, true, true>(cx.tid, lds, g, S, E);
}

__global__ void __launch_bounds__(512, 2) mega(Args a) {
    extern __shared__ __attribute__((aligned(16))) unsigned char lds_raw[];
    LAS unsigned char* lds = (LAS unsigned char*)lds_raw;
    cg::grid_group grid = cg::this_grid();
    volatile LAS unsigned* bst = (volatile LAS unsigned*)(lds + XB_LDS_OFF);
    if (threadIdx.x < 2) bst[threadIdx.x] = 0u;
    __syncthreads();
    XcdBarrier xbar = xcd_barrier_post((unsigned*)a.ws, bst);
    unsigned char* ws = a.ws;
    float* X = a.out;
    bf16* H = (bf16*)(ws + WS_H); bf16* P = (bf16*)(ws + WS_P); float* KV = (float*)(ws + WS_KV); bf16* YMIX = (bf16*)(ws + WS_YMIX);
    bf16* LRB = (bf16*)(ws + WS_LR); bf16* SP = (bf16*)(ws + WS_SP); const bf16* GUT = (const bf16*)(ws + WS_GUT); float* DEC = (float*)(ws + WS_DEC); float* Y = (float*)(ws + WS_Y); bf16* U = (bf16*)(ws + WS_U); bf16* G = (bf16*)(ws + WS_G);
    for (int p = a.ph_lo; p < a.ph_hi; ++p) {
        const int l = p / PH_PER_LAYER, k = p % PH_PER_LAYER;
        const int nrep = (l < DEPTH && ((REPEAT_MASK >> k) & 1)) ? 2 : 1;
        for (int rep = 0; rep < nrep; ++rep) {
        if (rep) xcd_barrier(xbar);
        Ctx cx; { int t_ = threadIdx.x, b_ = blockIdx.x, n_ = gridDim.x; asm volatile("" : "+v"(t_)); asm volatile("" : "+s"(b_), "+s"(n_)); cx.tid = t_; cx.bid = b_; cx.nb = n_; }
        if (l == DEPTH) {
#if PHASE_MASK & 1
            rows_phase(cx, X, Y, a.in[4] + (DEPTH - 1) * DM, nullptr, X, nullptr);
#endif
        } else if (k == 0) {
#if PHASE_MASK & 2
            convert_phase(cx, a.in[5] + (size_t)l * DM * DIN, a.in[12] + (size_t)l * DM * DM, a.in[13] + (size_t)l * DM * NUP, a.in[15] + (size_t)l * DFF * DM, a.in[7] + l * 16 * 256, a.in[9] + l * 16 * 256, ws, lds);
#endif
#if PHASE_MASK & 1
            rows_phase(cx, l == 0 ? a.in[0] : X, l == 0 ? nullptr : Y, a.in[4] + (l > 0 ? l - 1 : 0) * DM, a.in[1] + l * DM, X, H);
#endif
            __syncthreads();
        } else if (k == 1 || k == 7) {
#if PHASE_MASK & 4
            pg8::EpiBf16 E{k == 1 ? P : U, k == 1 ? NP : NUP}; run_gemm(cx, lds, H, (const bf16*)(ws + (k == 1 ? WS_WIN : WS_WUP)), k == 1 ? NP : NUP, DM, E);
#endif
#if PHASE_MASK & 8
            if (k == 1) lr_phase(cx, H, (const bf16*)(ws + WS_WLR), LRB, lds);
#endif
        } else if (k == 2 || k == 4) {
            GlaP g{P, LRB, GUT, a.in[8] + l * 256, a.in[10] + l * 256, a.in[11] + l * 128, KV, DEC, SP, YMIX};
            if (k == 2) {
#if PHASE_MASK & 16
                gla_pass1(cx, g, lds);
#endif
#if PHASE_MASK & 32
                conva_phase(cx, P, a.in[6] + l * 3 * 512, YMIX);
#endif
            } else {
#if PHASE_MASK & 64
                gla_pass3(cx, g, lds);
#endif
            }
        } else if (k == 3) {
#if PHASE_MASK & 128
            gla_scan(cx, KV, DEC, SP);
#endif
        } else if (k == 5 || k == 9) {
#if PHASE_MASK & 256
            pg8::EpiF32 E{Y, DM}; run_gemm(cx, lds, k == 5 ? YMIX : G, (const bf16*)(ws + (k == 5 ? WS_WOUT : WS_WDOWN)), DM, k == 5 ? DM : DFF, E);
#endif
        } else if (k == 6) {
#if PHASE_MASK & 1
            rows_phase(cx, X, Y, a.in[2] + l * DM, a.in[3] + l * DM, X, H);
#endif
        } else {
#if PHASE_MASK & 512
            ffn_conv_phase(cx, U, a.in[14] + (size_t)l * 3 * NUP, G);
#endif
        }
        }
        if (p + 1 < a.ph_hi) { if (p == a.ph_lo) grid.sync(); else xcd_barrier(xbar); }
    }
}

#ifndef ONE_LAUNCH
#define ONE_LAUNCH 0
#endif
extern "C" void kernel_launch(void* const* d_in, const int* in_sizes, int n_in, void* d_out, int out_size, void* d_ws, size_t ws_size, hipStream_t stream) {
    static int grid = 0;
    if (grid == 0) {
        if (n_in != 16 || out_size != M * DM || ws_size < WS_END) { fprintf(stderr, "kernel_launch: unexpected shapes (n_in %d out %d ws %zu)\n", n_in, out_size, ws_size); grid = -1; return; }
        int dev = 0, cus = 0, per_cu = 0;
        hipGetDevice(&dev); hipDeviceGetAttribute(&cus, hipDeviceAttributeMultiprocessorCount, dev);
        hipFuncSetAttribute((const void*)mega, hipFuncAttributeMaxDynamicSharedMemorySize, LDS_BYTES);
        hipOccupancyMaxActiveBlocksPerMultiprocessor(&per_cu, (const void*)mega, 512, LDS_BYTES);
        if (per_cu < 1) { fprintf(stderr, "kernel_launch: occupancy query says %d\n", per_cu); per_cu = 1; }
        grid = cus * per_cu;
        (void)hipGetLastError();
    }
    if (grid < 0) return;
    Args a{};
    for (int i = 0; i < 16; ++i) a.in[i] = (const float*)d_in[i];
    a.out = (float*)d_out; a.ws = (unsigned char*)d_ws;
#if ONE_LAUNCH
    (void)hipMemsetAsync(d_ws, 0, 16384, stream);
    a.ph_lo = 0; a.ph_hi = N_PHASES;
    void* args[] = {&a};
    hipError_t e = hipLaunchCooperativeKernel((const void*)mega, dim3(grid), dim3(512), args, LDS_BYTES, stream);
    if (e != hipSuccess) fprintf(stderr, "cooperative launch failed: %s (grid %d)\n", hipGetErrorString(e), grid);
#else
    for (int p = 0; p < N_PHASES; ++p) { a.ph_lo = p; a.ph_hi = p + 1; hipLaunchKernelGGL(mega, dim3(grid), dim3(512), LDS_BYTES, stream, a); }
#endif
}
```
